# Optimizing an MI355X kernel written in HIP

```python
import math, functools
import jax, jax.numpy as jnp
from jax import lax
import numpy as np

D_MODEL = 2048
BATCH = 2
SEQ = 4096
DEPTH = 4
DEC_BATCH = 32
DEC_SEQ = 8
PAST_LEN = 16384
PAGE_SIZE = 128

HEAD_DIM = 64
N_HEADS = D_MODEL // 128
N_KV_HEADS = N_HEADS // 4
Q_GROUP = N_HEADS // N_KV_HEADS
ATTN_W = N_HEADS * HEAD_DIM
KV_W = N_KV_HEADS * HEAD_DIM
WINDOW = 128
ATTN_BLOCK = 128
ROPE_THETA = 10000.0
SGU_CHUNK = 128
SGU_W = D_MODEL // 2
SGU_GROUPS = 8
SGU_CH = SGU_W // SGU_GROUPS
D_FF = 4 * D_MODEL
RMS_EPS = 1e-6
LN_EPS = 1e-5
NEG_INF = -1e30
SPLITS = (ATTN_W, ATTN_W + KV_W, ATTN_W + 2 * KV_W, ATTN_W + 2 * KV_W + SGU_W,
          ATTN_W + 2 * KV_W + 2 * SGU_W, ATTN_W + 2 * KV_W + 2 * SGU_W + D_MODEL)
IN_COLS = ATTN_W + 2 * KV_W + 2 * SGU_W + 2 * D_MODEL

kernel_name = "hybrid_swa_sink_sgu_gated_decoder_step"


def rms_norm(x, g):
    xf = x.astype(jnp.float32)
    y = xf * lax.rsqrt(jnp.mean(xf * xf, axis=-1, keepdims=True) + RMS_EPS)
    return (y * g.astype(jnp.float32)).astype(x.dtype)


def layer_norm(x, g, b):
    xf = x.astype(jnp.float32)
    mu = jnp.mean(xf, axis=-1, keepdims=True)
    var = jnp.mean(jnp.square(xf - mu), axis=-1, keepdims=True)
    y = (xf - mu) * lax.rsqrt(var + LN_EPS)
    return (y * g.astype(jnp.float32) + b.astype(jnp.float32)).astype(x.dtype)


def rope(x, pos):
    half = HEAD_DIM // 2
    inv = jnp.power(jnp.float32(ROPE_THETA), -jnp.arange(half, dtype=jnp.float32) / half)
    ang = pos.astype(jnp.float32)[:, None] * inv[None, :]
    cos = jnp.cos(ang)[:, None, :]
    sin = jnp.sin(ang)[:, None, :]
    xf = x.astype(jnp.float32)
    x1, x2 = xf[..., :half], xf[..., half:]
    return jnp.concatenate([x1 * cos - x2 * sin, x2 * cos + x1 * sin], axis=-1).astype(x.dtype)


def sink_attention(q, k, v, mask, sink):
    scale = HEAD_DIM ** -0.5
    s = jnp.einsum('...qhgd,...khd->...hgqk', q, k).astype(jnp.float32) * scale
    s = jnp.where(mask, s, NEG_INF)
    sk = sink.astype(jnp.float32).reshape(N_KV_HEADS, Q_GROUP, 1, 1)
    m = jnp.maximum(jnp.max(s, axis=-1, keepdims=True), sk)
    p = jnp.exp(s - m)
    p = p / (jnp.sum(p, axis=-1, keepdims=True) + jnp.exp(sk - m))
    return jnp.einsum('...hgqk,...khd->...qhgd', p.astype(v.dtype), v)


def swa_prompt(q, k, v, sink):
    B, L = q.shape[0], q.shape[1]
    nb = L // ATTN_BLOCK
    qb = q.reshape(B, nb, ATTN_BLOCK, N_KV_HEADS, Q_GROUP, HEAD_DIM)

    def with_prev(t):
        tb = t.reshape(B, nb, ATTN_BLOCK, N_KV_HEADS, HEAD_DIM)
        prev = jnp.pad(tb[:, :-1], ((0, 0), (1, 0), (0, 0), (0, 0), (0, 0)))
        return jnp.concatenate([prev, tb], axis=2)

    kk, vv = with_prev(k), with_prev(v)
    qi = jnp.arange(ATTN_BLOCK)[:, None]
    kj = jnp.arange(2 * ATTN_BLOCK)[None, :]
    diff = qi + ATTN_BLOCK - kj
    band = (diff >= 0) & (diff < WINDOW)
    blk = jnp.arange(nb)[:, None, None]
    key_valid = (blk - 1) * ATTN_BLOCK + kj[None] >= 0
    mask = (band[None] & key_valid)[:, None, None]
    o = sink_attention(qb, kk, vv, mask, sink)
    return o.reshape(B, L, ATTN_W), k[:, -WINDOW:], v[:, -WINDOW:]


def swa_sample(q, k, v, sink, ck, cv):
    Bd, S = q.shape[0], q.shape[1]
    kk = jnp.concatenate([ck.astype(k.dtype), k], axis=1)
    vv = jnp.concatenate([cv.astype(v.dtype), v], axis=1)
    q_pos = PAST_LEN + jnp.arange(S)
    k_pos = PAST_LEN - WINDOW + jnp.arange(WINDOW + S)
    diff = q_pos[:, None] - k_pos[None, :]
    mask = (diff >= 0) & (diff < WINDOW)
    qg = q.reshape(Bd, S, N_KV_HEADS, Q_GROUP, HEAD_DIM)
    o = sink_attention(qg, kk, vv, mask, sink)
    return o.reshape(Bd, S, ATTN_W), kk[:, -WINDOW:], vv[:, -WINDOW:]


def spatial_gate(u, v, w_s, b_s):
    B, L = v.shape[0], v.shape[1]
    csz = min(L, SGU_CHUNK)
    pad = (-L) % csz
    vp = jnp.pad(v, ((0, 0), (0, pad), (0, 0), (0, 0)))
    n = (L + pad) // csz
    vc = vp.reshape(B, n, csz, SGU_GROUPS, SGU_CH)
    tril = jnp.tril(jnp.ones((csz, csz), dtype=bool))
    w = jnp.where(tril[None], w_s[:, :csz, :csz], jnp.zeros((), w_s.dtype))
    mixed = jnp.einsum('gts,bnsgc->bntgc', w, vc) + b_s[:, :csz].T[None, None, :, :, None]
    mixed = mixed.reshape(B, n * csz, SGU_GROUPS, SGU_CH)[:, :L]
    return u * mixed


def block(x, pos, attend, n1, w_in, qg, kg, sink, ln_g, ln_b, sgu_w, sgu_b,
          w_au, w_su, w_out, n2, w1, w2):
    B, L = x.shape[0], x.shape[1]
    xn = rms_norm(x, n1)
    q, k, v, u, vs, ga, gm = jnp.split(xn @ w_in, SPLITS, axis=-1)
    q = rope(rms_norm(q.reshape(B, L, N_HEADS, HEAD_DIM), qg), pos)
    k = rope(rms_norm(k.reshape(B, L, N_KV_HEADS, HEAD_DIM), kg), pos)
    v = v.reshape(B, L, N_KV_HEADS, HEAD_DIM)
    a, k_state, v_state = attend(q, k, v, sink)
    u = jax.nn.gelu(u, approximate=False).reshape(B, L, SGU_GROUPS, SGU_CH)
    vs = layer_norm(jax.nn.gelu(vs, approximate=False), ln_g, ln_b).reshape(B, L, SGU_GROUPS, SGU_CH)
    m = spatial_gate(u, vs, sgu_w, sgu_b).reshape(B, L, SGU_W)
    merged = jax.nn.sigmoid(ga) * (a @ w_au) + jax.nn.sigmoid(gm) * (m @ w_su)
    h = x + merged @ w_out
    y = h + jnp.square(jax.nn.relu(rms_norm(h, n2) @ w1)) @ w2
    return y, k_state, v_state, vs


def setup_inputs(seed: int = 0) -> dict:
    key = jax.random.key(seed)
    ks = jax.random.split(key, 20)
    f32 = jnp.float32
    nrm = lambda k, shape, s: jax.random.normal(k, shape, f32) * s
    return {
        "x_prompt": nrm(ks[0], (BATCH, SEQ, D_MODEL), 1.0),
        "x_sample": nrm(ks[1], (DEC_BATCH, DEC_SEQ, D_MODEL), 1.0),
        "cache_k": nrm(ks[2], (DEPTH, DEC_BATCH, WINDOW, N_KV_HEADS, HEAD_DIM), 1.0),
        "cache_v": nrm(ks[3], (DEPTH, DEC_BATCH, WINDOW, N_KV_HEADS, HEAD_DIM), 1.0),
        "norm1_g": 1.0 + nrm(ks[4], (DEPTH, D_MODEL), 0.02),
        "w_in": nrm(ks[5], (DEPTH, D_MODEL, IN_COLS), D_MODEL ** -0.5),
        "q_norm_g": 1.0 + nrm(ks[6], (DEPTH, HEAD_DIM), 0.02),
        "k_norm_g": 1.0 + nrm(ks[7], (DEPTH, HEAD_DIM), 0.02),
        "attn_sinks": nrm(ks[8], (DEPTH, N_HEADS), 1.0),
        "sgu_ln_g": 1.0 + nrm(ks[9], (DEPTH, SGU_W), 0.02),
        "sgu_ln_b": nrm(ks[10], (DEPTH, SGU_W), 0.02),
        "sgu_w": nrm(ks[11], (DEPTH, SGU_GROUPS, SGU_CHUNK, SGU_CHUNK), SGU_CHUNK ** -0.5),
        "sgu_b": 1.0 + nrm(ks[12], (DEPTH, SGU_GROUPS, SGU_CHUNK), 0.02),
        "w_attn_up": nrm(ks[13], (DEPTH, ATTN_W, D_MODEL), ATTN_W ** -0.5),
        "w_sgu_up": nrm(ks[14], (DEPTH, SGU_W, D_MODEL), SGU_W ** -0.5),
        "w_out": nrm(ks[15], (DEPTH, D_MODEL, D_MODEL), D_MODEL ** -0.5),
        "norm2_g": 1.0 + nrm(ks[16], (DEPTH, D_MODEL), 0.02),
        "w_ff1": nrm(ks[17], (DEPTH, D_MODEL, D_FF), D_MODEL ** -0.5),
        "w_ff2": nrm(ks[18], (DEPTH, D_FF, D_MODEL), D_FF ** -0.5),
    }


def reference(x_prompt, x_sample, cache_k, cache_v, norm1_g, w_in, q_norm_g, k_norm_g,
              attn_sinks, sgu_ln_g, sgu_ln_b, sgu_w, sgu_b, w_attn_up, w_sgu_up, w_out,
              norm2_g, w_ff1, w_ff2):
    pos_p = jnp.arange(x_prompt.shape[1])
    pos_s = PAST_LEN + jnp.arange(x_sample.shape[1])
    xp, xs = x_prompt, x_sample
    kp_l, vp_l, ks_l, vs_l, sv_l = [], [], [], [], []
    for l in range(DEPTH):
        params = (norm1_g[l], w_in[l], q_norm_g[l], k_norm_g[l], attn_sinks[l], sgu_ln_g[l],
                  sgu_ln_b[l], sgu_w[l], sgu_b[l], w_attn_up[l], w_sgu_up[l], w_out[l],
                  norm2_g[l], w_ff1[l], w_ff2[l])
        xp, kp, vp, _ = block(xp, pos_p, swa_prompt, *params)
        sample_attend = functools.partial(swa_sample, ck=cache_k[l], cv=cache_v[l])
        xs, ksn, vsn, sgu_v = block(xs, pos_s, sample_attend, *params)
        kp_l.append(kp); vp_l.append(vp); ks_l.append(ksn); vs_l.append(vsn); sv_l.append(sgu_v)
    new_k_prompt = jnp.stack(kp_l)
    new_v_prompt = jnp.stack(vp_l)
    new_k_sample = jnp.stack(ks_l)
    new_v_sample = jnp.stack(vs_l)
    new_sgu_v_sample = jnp.stack(sv_l)
    return (xp, xs, new_k_prompt, new_v_prompt, new_k_sample, new_v_sample, new_sgu_v_sample)
```

```cpp
#include <hip/hip_runtime.h>
#include <hip/hip_cooperative_groups.h>
#include <cstdio>
#include <cstdint>
namespace cg = cooperative_groups;
namespace pg8 {
#define PG8_LAS __attribute__((address_space(3)))
typedef unsigned short bf16_t;
typedef short bf16x8 __attribute__((ext_vector_type(8)));
typedef float f32x4 __attribute__((ext_vector_type(4)));
typedef unsigned u32x4 __attribute__((ext_vector_type(4)));
constexpr int BM = 256, BK = 64, HALF = 128, HTB = HALF * BK * 2  , STAGE_BYTES = 8 * HTB, NXCD = 8, WGM = 8;

__host__ __device__ __forceinline__ int lds_byte(int r, int c) { const int st = (r >> 4) * 2 + (c >> 5), rr = r & 15, cc = c & 31, ob = rr * 64 + cc * 2; return st * 1024 + (ob ^ (((ob >> 9) & 1) << 5)); }
__host__ __device__ __forceinline__ void stage_rc(int b, int& R, int& C) { const int st = b / 1024, sb = b % 1024, swz = sb ^ (((sb >> 9) & 1) << 5); R = (st >> 1) * 16 + swz / 64; C = (st & 1) * 32 + (swz % 64) / 2; }
__host__ __device__ __forceinline__ int perm32(int rho) { const int n = rho >> 4, i = rho & 15; return 8 * (i >> 2) + 4 * n + (i & 3); }

struct Unit { int pm, pn, k0, ks; };
struct Gemm { const bf16_t* A; const bf16_t* Bt; int M, N, K, ld; };

struct StaticOrder {
    int nM, nN, nwg, G, c;
    __host__ __device__ void init(int M, int N, int G_, int c_) { nM = M / BM; nN = N / BM; nwg = nM * nN; G = G_; c = c_; }
    __host__ __device__ bool next(int i, Unit& u) const {
        const long L = (long)i * G + c; if (L >= nwg) return false;
        int wgid = (int)L; { const int q = nwg / NXCD, r = nwg % NXCD, xcd = wgid % NXCD, off = wgid / NXCD; wgid = (xcd < r ? xcd * (q + 1) : r * (q + 1) + (xcd - r) * q) + off; }
        const int nig = WGM * nN, gid = wgid / nig, fm = gid * WGM, gsz = (nM - fm) < WGM ? (nM - fm) : WGM;
        u.pm = fm + ((wgid % nig) % gsz); u.pn = (wgid % nig) / gsz; u.k0 = 0; u.ks = 0; return true;
    }
    __device__ __forceinline__ void a_ready(const Unit&) const {}
    __device__ __forceinline__ void done(const Unit&) const {}
};

__device__ __forceinline__ unsigned cvt_pk_bf16(float lo, float hi) { unsigned r; asm volatile("v_cvt_pk_bf16_f32 %0, %1, %2" : "=v"(r) : "v"(lo), "v"(hi)); return r; }
typedef float f32x2 __attribute__((ext_vector_type(2)));
__device__ __forceinline__ f32x2 gelu_pk(f32x2 v) {
    const f32x2 av = __builtin_elementwise_abs(v), d = av * 0.2316418882f + 1.0f;
    f32x2 t; t.x = __builtin_amdgcn_rcpf(d.x); t.y = __builtin_amdgcn_rcpf(d.y);
    f32x2 q = t * 0.5307027145f + (-0.7265760135f); q = q * t + 0.7107068705f; q = q * t + (-0.142248368f); q = q * t + 0.127414796f; q = q * t;
    const f32x2 s = (v * v) * (-0.72134752044f);
    f32x2 e; e.x = __builtin_amdgcn_exp2f(s.x); e.y = __builtin_amdgcn_exp2f(s.y);
    const f32x2 m = v * (q * e), r = v - m;
    f32x2 o; o.x = v.x < 0.f ? m.x : r.x; o.y = v.y < 0.f ? m.y : r.y; return o;
}

template <int ACT  > struct EpiBf16 {
    static constexpr bool PERM = true, AFTER_DRAIN = false, HAS_MID = false, HAS_INIT = false; static_assert(ACT == 0 || ACT == 1, "EpiBf16: ACT is 0 (none) or 1 (gelu_pk)");
    bf16_t* O; int ldc; const float* bias; int split_cols; size_t split_stride; float scale0;
    __device__ __forceinline__ void operator()(const f32x4 (&acc)[2][2][4][2], const Unit& u, int wr, int wc, int fr, int fq) const {
        const int row0 = u.pm * BM + wr * 64 + fr; int colt = u.pn * BM; bf16_t* base = O;
        float sc = 1.f; if (split_cols) { const int t = colt / split_cols; base += (size_t)t * split_stride; colt -= t * split_cols; if (t == 0) sc = scale0; }
        const int col0 = colt + wc * 32 + 8 * fq, bcol0 = u.pn * BM + wc * 32 + 8 * fq;
        f32x4 bv[2][2];
#pragma unroll
        for (int bj = 0; bj < 2; ++bj)
#pragma unroll
            for (int n = 0; n < 2; ++n) bv[bj][n] = bias ? *(const f32x4*)(bias + bcol0 + bj * HALF + 4 * n) : (f32x4){0.f, 0.f, 0.f, 0.f};
#pragma unroll
        for (int ai = 0; ai < 2; ++ai)
#pragma unroll
            for (int m = 0; m < 4; ++m) { bf16_t* rowp = base + (size_t)(row0 + ai * HALF + m * 16) * ldc + col0;
#pragma unroll
                for (int bj = 0; bj < 2; ++bj) { f32x4 v0 = acc[ai][bj][m][0] + bv[bj][0], v1 = acc[ai][bj][m][1] + bv[bj][1];
                    if (ACT == 1) { f32x2 a = gelu_pk((f32x2){v0[0], v0[1]}), b = gelu_pk((f32x2){v0[2], v0[3]}), c = gelu_pk((f32x2){v1[0], v1[1]}), d = gelu_pk((f32x2){v1[2], v1[3]});
                        v0 = (f32x4){a.x, a.y, b.x, b.y}; v1 = (f32x4){c.x, c.y, d.x, d.y}; }
                    v0 = v0 * sc; v1 = v1 * sc; u32x4 w; w.x = cvt_pk_bf16(v0[0], v0[1]); w.y = cvt_pk_bf16(v0[2], v0[3]); w.z = cvt_pk_bf16(v1[0], v1[1]); w.w = cvt_pk_bf16(v1[2], v1[3]);
                    *(u32x4*)(rowp + bj * HALF) = w; } }
    }
};

template <class Epi, class Sched, bool ALIGN_EPI = false, bool SP2 = false>
__device__ __forceinline__ void gemm_phase(PG8_LAS unsigned char* lds, const Gemm g, const Sched& S, const Epi& E) {
    int tid_raw = threadIdx.x; asm volatile("" : "+v"(tid_raw));
    const int tid = tid_raw, wid = __builtin_amdgcn_readfirstlane(tid >> 6), lane = tid & 63, wr = wid >> 2, wc = wid & 3, fr = lane & 15, fq = lane >> 4;
    const int K = g.ld, nt = g.K / BK;
    unsigned voffA[2], voffB[2];
#pragma unroll
    for (int i = 0; i < 2; ++i) { int R, C; stage_rc(tid * 16 + i * 8192, R, C); const int Rb = Epi::PERM ? ((R & ~31) + perm32(R & 31)) : R;
        voffA[i] = (unsigned)(R * K + C) * 2u; voffB[i] = (unsigned)(Rb * K + C) * 2u; }
    const size_t kstep = (size_t)(BK * 2);
    const size_t hstep = (size_t)HALF * K * 2;
    const size_t tstep = 2 * hstep;
    const unsigned ldsw = (unsigned)wid * 1024u;
    const int aoff = lds_byte(wr * 64 + fr, fq * 8), boff = lds_byte(wc * 32 + fr, fq * 8);
#define PG8_SA(b, h) (((b) * 2 + (h)) * HTB)
#define PG8_SB(b, h) ((4 + (b) * 2 + (h)) * HTB)
#define PG8_STAGE(bufoff, gbase, voff) do { _Pragma("unroll") for (int _i = 0; _i < 2; ++_i) \
        __builtin_amdgcn_global_load_lds((const unsigned*)((const char*)(gbase) + (voff)[_i]), (PG8_LAS unsigned*)(lds + (bufoff) + ldsw + _i * 8192), 16, 0, 0); } while (0)
#define PG8_LDA(dst, b, h) do { _Pragma("unroll") for (int m = 0; m < 4; ++m) _Pragma("unroll") for (int k = 0; k < 2; ++k) dst[m][k] = *(const PG8_LAS bf16x8*)(lds + PG8_SA(b, h) + aoff + m * 2048 + k * 1024); } while (0)
#define PG8_LDB(dst, b, h) do { _Pragma("unroll") for (int n = 0; n < 2; ++n) _Pragma("unroll") for (int k = 0; k < 2; ++k) dst[n][k] = *(const PG8_LAS bf16x8*)(lds + PG8_SB(b, h) + boff + n * 2048 + k * 1024); } while (0)
#define PG8_MMA(ai, bj, At, Bt) do { __builtin_amdgcn_s_setprio(1); _Pragma("unroll") for (int m = 0; m < 4; ++m) _Pragma("unroll") for (int n = 0; n < 2; ++n) _Pragma("unroll") for (int k = 0; k < 2; ++k) \
        acc[ai][bj][m][n] = __builtin_amdgcn_mfma_f32_16x16x32_bf16(Bt[n][k], At[m][k], acc[ai][bj][m][n], 0, 0, 0); __builtin_amdgcn_s_setprio(0); } while (0)
#define PG8_WAIT_V(n) asm volatile("s_waitcnt vmcnt(" #n ")" ::: "memory")
#define PG8_WAIT_L(n) asm volatile("s_waitcnt lgkmcnt(" #n ")" ::: "memory")
#define PG8_BAR __builtin_amdgcn_s_barrier()
#define PG8_SCHED __builtin_amdgcn_sched_barrier(0)
    Unit cur, nxt; int ui = 0;
    if (!S.next(0, cur)) return;
    f32x4 acc[2][2][4][2];
    if constexpr (Epi::HAS_INIT) E.init(acc, cur, wr, wc, fr, fq);
    else {
#pragma unroll
    for (int a = 0; a < 2; ++a)
#pragma unroll
        for (int b = 0; b < 2; ++b)
#pragma unroll
            for (int m = 0; m < 4; ++m)
#pragma unroll
                for (int n = 0; n < 2; ++n) acc[a][b][m][n] = (f32x4){0.f, 0.f, 0.f, 0.f};
    }
    bf16x8 At[4][2], B0[2][2], B1[2][2];
    const char* cA = (const char*)g.A + (size_t)cur.pm * tstep + (size_t)cur.k0 * 2; const char* cB = (const char*)g.Bt + (size_t)cur.pn * tstep + (size_t)cur.k0 * 2;
    S.a_ready(cur);
    if constexpr (SP2) {
        PG8_STAGE(PG8_SB(0, 0), cB, voffB); PG8_STAGE(PG8_SB(0, 1), cB + hstep, voffB); PG8_STAGE(PG8_SA(0, 0), cA, voffA); PG8_STAGE(PG8_SA(0, 1), cA + hstep, voffA);
        if (wr == 1) PG8_BAR;
        PG8_WAIT_V(2); PG8_BAR;
        PG8_STAGE(PG8_SB(1, 0), cB + kstep, voffB); PG8_STAGE(PG8_SA(1, 0), cA + kstep, voffA); PG8_STAGE(PG8_SB(1, 1), cB + hstep + kstep, voffB);
        PG8_WAIT_V(6); PG8_BAR;
    } else {
        PG8_STAGE(PG8_SB(0, 0), cB, voffB); PG8_STAGE(PG8_SA(0, 0), cA, voffA); PG8_STAGE(PG8_SB(0, 1), cB + hstep, voffB); PG8_STAGE(PG8_SA(0, 1), cA + hstep, voffA);
        if (wr == 1) PG8_BAR;
        PG8_WAIT_V(4); PG8_BAR;
        PG8_STAGE(PG8_SB(1, 0), cB + kstep, voffB); PG8_STAGE(PG8_SA(1, 0), cA + kstep, voffA); PG8_STAGE(PG8_SB(1, 1), cB + hstep + kstep, voffB);
        PG8_WAIT_V(6); PG8_BAR;
    }
    if constexpr (Epi::HAS_INIT) {
#pragma unroll
        for (int a = 0; a < 2; ++a)
#pragma unroll
            for (int b = 0; b < 2; ++b)
#pragma unroll
                for (int m = 0; m < 4; ++m) asm volatile("" : "+v"(acc[a][b][m][0]), "+v"(acc[a][b][m][1]));
    }
    for (;;) {
        const bool has_next = S.next(ui + 1, nxt);
        const char* nA = has_next ? (const char*)g.A + (size_t)nxt.pm * tstep + (size_t)nxt.k0 * 2 : cA; const char* nB = has_next ? (const char*)g.Bt + (size_t)nxt.pn * tstep + (size_t)nxt.k0 * 2 : cB;
        for (int t = 0; t < nt; t += 2) {
            if constexpr (Epi::HAS_MID) { if (t == nt / 2) E.mid(acc, cur, wr, wc, fr, fq); }
            const bool last = (t == nt - 2);
            const char* a1 = cA + (size_t)(t + 1) * kstep;
            const char* a2 = last ? nA : cA + (size_t)(t + 2) * kstep; const char* b2 = last ? nB : cB + (size_t)(t + 2) * kstep;
            const char* a3 = a2 + kstep; const char* b3 = b2 + kstep;
            if (last && has_next) S.a_ready(nxt);
            if constexpr (SP2) {
            PG8_LDB(B0, 0, 0); PG8_LDB(B1, 0, 1); PG8_SCHED; PG8_LDA(At, 0, 0); PG8_STAGE(PG8_SA(1, 1), a1 + hstep, voffA);
            PG8_WAIT_V(8); PG8_WAIT_L(0); PG8_BAR; PG8_MMA(0, 0, At, B0); PG8_MMA(0, 1, At, B1); PG8_BAR; PG8_SCHED;
            PG8_LDA(At, 0, 1); PG8_STAGE(PG8_SB(0, 0), b2, voffB); PG8_STAGE(PG8_SB(0, 1), b2 + hstep, voffB); PG8_STAGE(PG8_SA(0, 0), a2, voffA);
            PG8_WAIT_V(8); PG8_WAIT_L(0); PG8_BAR; PG8_MMA(1, 0, At, B0); PG8_MMA(1, 1, At, B1); PG8_BAR; PG8_SCHED;
            PG8_LDB(B0, 1, 0); PG8_LDB(B1, 1, 1); PG8_SCHED; PG8_LDA(At, 1, 0); PG8_STAGE(PG8_SA(0, 1), a2 + hstep, voffA);
            PG8_WAIT_V(8); PG8_WAIT_L(0); PG8_BAR; PG8_MMA(0, 0, At, B0); PG8_MMA(0, 1, At, B1); PG8_BAR; PG8_SCHED;
            PG8_LDA(At, 1, 1); PG8_STAGE(PG8_SB(1, 0), b3, voffB); PG8_STAGE(PG8_SB(1, 1), b3 + hstep, voffB); PG8_STAGE(PG8_SA(1, 0), a3, voffA);
            PG8_WAIT_V(8); PG8_WAIT_L(0); PG8_BAR; PG8_MMA(1, 0, At, B0); PG8_MMA(1, 1, At, B1); PG8_BAR; PG8_SCHED;
            } else {
            PG8_LDB(B0, 0, 0); PG8_SCHED; PG8_LDA(At, 0, 0); PG8_STAGE(PG8_SA(1, 1), a1 + hstep, voffA);
            PG8_WAIT_L(8); PG8_BAR; PG8_WAIT_L(0); PG8_MMA(0, 0, At, B0); PG8_BAR; PG8_SCHED;
            PG8_LDB(B1, 0, 1); PG8_STAGE(PG8_SB(0, 0), b2, voffB);
            PG8_BAR; PG8_WAIT_L(0); PG8_MMA(0, 1, At, B1); PG8_BAR;
            PG8_LDA(At, 0, 1); PG8_STAGE(PG8_SA(0, 0), a2, voffA);
            PG8_BAR; PG8_WAIT_L(0); PG8_MMA(1, 0, At, B0); PG8_BAR; PG8_SCHED;
            PG8_STAGE(PG8_SB(0, 1), b2 + hstep, voffB);
            PG8_WAIT_V(6); PG8_BAR; PG8_MMA(1, 1, At, B1); PG8_BAR;
            PG8_LDB(B0, 1, 0); PG8_SCHED; PG8_LDA(At, 1, 0); PG8_STAGE(PG8_SA(0, 1), a2 + hstep, voffA);
            PG8_WAIT_L(8); PG8_BAR; PG8_WAIT_L(0); PG8_MMA(0, 0, At, B0); PG8_BAR; PG8_SCHED;
            PG8_LDB(B1, 1, 1); PG8_STAGE(PG8_SB(1, 0), b3, voffB);
            PG8_BAR; PG8_WAIT_L(0); PG8_MMA(0, 1, At, B1); PG8_BAR;
            PG8_LDA(At, 1, 1); PG8_STAGE(PG8_SA(1, 0), a3, voffA);
            PG8_BAR; PG8_WAIT_L(0); PG8_MMA(1, 0, At, B0); PG8_BAR; PG8_SCHED;
            PG8_STAGE(PG8_SB(1, 1), b3 + hstep, voffB);
            PG8_WAIT_V(6); PG8_BAR; PG8_MMA(1, 1, At, B1); PG8_BAR;
            }
        }
        if constexpr (ALIGN_EPI) { if (wr == 0) PG8_BAR; }
        if constexpr (!Epi::AFTER_DRAIN) { E(acc, cur, wr, wc, fr, fq); S.done(cur); }
        if (!has_next) break;
        if constexpr (Epi::HAS_INIT) { E.init(acc, nxt, wr, wc, fr, fq);
#pragma unroll
            for (int a = 0; a < 2; ++a)
#pragma unroll
                for (int b = 0; b < 2; ++b)
#pragma unroll
                    for (int m = 0; m < 4; ++m) asm volatile("" : "+v"(acc[a][b][m][0]), "+v"(acc[a][b][m][1]));
        } else {
#pragma unroll
        for (int a = 0; a < 2; ++a)
#pragma unroll
            for (int b = 0; b < 2; ++b)
#pragma unroll
                for (int m = 0; m < 4; ++m)
#pragma unroll
                    for (int n = 0; n < 2; ++n) acc[a][b][m][n] = (f32x4){0.f, 0.f, 0.f, 0.f};
        }
        cur = nxt; cA = nA; cB = nB; ++ui;
        if constexpr (ALIGN_EPI) { if (wr == 1) PG8_BAR; }
    }
    PG8_WAIT_V(0);
    if constexpr (!ALIGN_EPI) { if (wr == 0) PG8_BAR; }
    PG8_BAR;
    if constexpr (Epi::AFTER_DRAIN) { E.fused(acc, cur, wr, wc, fr, fq, lds, wid, lane); S.done(cur); }
#undef PG8_SA
#undef PG8_SB
#undef PG8_STAGE
#undef PG8_LDA
#undef PG8_LDB
#undef PG8_MMA
#undef PG8_WAIT_V
#undef PG8_WAIT_L
#undef PG8_BAR
#undef PG8_SCHED
}
}

#define LAS __attribute__((address_space(3)))
typedef unsigned short bf16;
typedef float f32x4 __attribute__((ext_vector_type(4)));
typedef float f32x2 __attribute__((ext_vector_type(2)));
typedef unsigned u32x4 __attribute__((ext_vector_type(4)));
typedef unsigned u32x2 __attribute__((ext_vector_type(2)));
typedef short bf16x8 __attribute__((ext_vector_type(8)));
typedef short s16x4 __attribute__((ext_vector_type(4)));

constexpr int DM = 2048, SEQ = 4096, NPT = 8192, MTOK = 8448, NLAYER = 4;
constexpr int INC = 7680, FFD = 8192, AW = 1024, QKVW = 1536;
constexpr size_t MiB = 1u << 20;
constexpr size_t WS_WIN = 0, WS_WAU = 120 * MiB, WS_WSU = 136 * MiB, WS_WOUT = 152 * MiB, WS_W1 = 184 * MiB, WS_W2 = 312 * MiB;
constexpr size_t WS_XB = 440 * MiB, WS_QKV = 473 * MiB, WS_U = 498 * MiB, WS_VS = 515 * MiB, WS_GA = 532 * MiB, WS_GM = 565 * MiB;
constexpr size_t WS_AO = 598 * MiB, WS_MO = 615 * MiB, WS_MG = 632 * MiB, WS_F = 665 * MiB, WS_STAT = 797 * MiB, WS_CNT = 799 * MiB, WS_BAR = 799 * MiB + 65536, WS_PART = 800 * MiB, WS_END = 864 * MiB;
constexpr size_t WS_TMP = WS_F;
constexpr size_t O_KP = 17301504, O_VP = 17563648, O_KS = 17825792, O_VSAMP = 22020096, O_SGUV = 26214400, O_END = 27262976;
constexpr int LDS_BYTES = 147456;
constexpr float RMS_EPS = 1e-6f, LN_EPS = 1e-5f;

struct Params {
    const float *x_prompt, *x_sample, *cache_k, *cache_v, *norm1_g, *w_in, *q_norm_g, *k_norm_g, *sinks, *ln_g, *ln_b, *sgu_w, *sgu_b, *w_au, *w_su, *w_out, *norm2_g, *w_ff1, *w_ff2;
    float* out; unsigned char* ws;
};

__device__ __forceinline__ float bf_lo(unsigned w) { return __uint_as_float(w << 16); }
__device__ __forceinline__ float bf_hi(unsigned w) { return __uint_as_float(w & 0xffff0000u); }
__device__ __forceinline__ unsigned pk(float lo, float hi) { return pg8::cvt_pk_bf16(lo, hi); }
__device__ __forceinline__ void unpack8(u32x4 w, float* f) { f[0] = bf_lo(w.x); f[1] = bf_hi(w.x); f[2] = bf_lo(w.y); f[3] = bf_hi(w.y); f[4] = bf_lo(w.z); f[5] = bf_hi(w.z); f[6] = bf_lo(w.w); f[7] = bf_hi(w.w); }
__device__ __forceinline__ u32x4 pack8(const float* f) { u32x4 w; w.x = pk(f[0], f[1]); w.y = pk(f[2], f[3]); w.z = pk(f[4], f[5]); w.w = pk(f[6], f[7]); return w; }
__device__ __forceinline__ float wave_sum(float v) {
#pragma unroll
    for (int o = 1; o < 64; o <<= 1) v += __shfl_xor(v, o);
    return v;
}
typedef unsigned long long u64;
__device__ __forceinline__ float fx2f(u64 v) { return (float)(long long)v * (1.0f / 1048576.0f); }
__device__ __forceinline__ u64 f2fx(float s) { return (u64)(long long)(s * 1048576.0f); }
__device__ __forceinline__ void unpack8u(u32x2 w, float* f) { f[0] = (float)(w.x & 0xffu); f[1] = (float)((w.x >> 8) & 0xffu); f[2] = (float)((w.x >> 16) & 0xffu); f[3] = (float)(w.x >> 24);
    f[4] = (float)(w.y & 0xffu); f[5] = (float)((w.y >> 8) & 0xffu); f[6] = (float)((w.y >> 16) & 0xffu); f[7] = (float)(w.y >> 24); }
__device__ __forceinline__ float sigmoidf_(float x) { return __builtin_amdgcn_rcpf(1.0f + __expf(-x)); }

struct EpiIn {
    static constexpr bool PERM = true, AFTER_DRAIN = false, HAS_MID = false, HAS_INIT = false;
    const u64* ssq; bf16 *QKV, *U, *VS, *GA, *GM; u64* vstat;
    __device__ __forceinline__ void operator()(const f32x4 (&acc)[2][2][4][2], const pg8::Unit& u, int wr, int wc, int fr, int fq) const {
        const int pn = u.pn, row0 = u.pm * 256 + wr * 64 + fr, cw = wc * 32 + 8 * fq;
        int kind, ld, colt; bf16* base;
        if (pn < 6) { kind = 0; base = QKV; ld = QKVW; colt = pn * 256; }
        else if (pn < 10) { kind = 1; base = U; ld = 1024; colt = (pn - 6) * 256; }
        else if (pn < 14) { kind = 2; base = VS; ld = 1024; colt = (pn - 10) * 256; }
        else if (pn < 22) { kind = 3; base = GA; ld = DM; colt = (pn - 14) * 256; }
        else { kind = 3; base = GM; ld = DM; colt = (pn - 22) * 256; }
#pragma unroll
        for (int ai = 0; ai < 2; ++ai)
#pragma unroll
            for (int m = 0; m < 4; ++m) {
                const int row = row0 + ai * 128 + m * 16;
                const float rs = rsqrtf(fx2f(ssq[row]) * (1.0f / DM) + RMS_EPS);
                float s1 = 0.f, s2 = 0.f;
#pragma unroll
                for (int bj = 0; bj < 2; ++bj) {
                    f32x4 v0 = acc[ai][bj][m][0] * rs, v1 = acc[ai][bj][m][1] * rs;
                    if (kind == 1 || kind == 2) {
                        pg8::f32x2 a = pg8::gelu_pk((pg8::f32x2){v0[0], v0[1]}), b = pg8::gelu_pk((pg8::f32x2){v0[2], v0[3]}), c = pg8::gelu_pk((pg8::f32x2){v1[0], v1[1]}), d = pg8::gelu_pk((pg8::f32x2){v1[2], v1[3]});
                        v0 = (f32x4){a.x, a.y, b.x, b.y}; v1 = (f32x4){c.x, c.y, d.x, d.y};
                        if (kind == 2) { s1 += (v0[0] + v0[1]) + (v0[2] + v0[3]) + (v1[0] + v1[1]) + (v1[2] + v1[3]);
                            s2 += (v0[0] * v0[0] + v0[1] * v0[1]) + (v0[2] * v0[2] + v0[3] * v0[3]) + (v1[0] * v1[0] + v1[1] * v1[1]) + (v1[2] * v1[2] + v1[3] * v1[3]); }
                    } else if (kind == 3) {
                        unsigned q0 = 0u, q1 = 0u;
#pragma unroll
                        for (int k = 0; k < 4; ++k) { q0 = __builtin_amdgcn_cvt_pk_u8_f32(fmaxf(sigmoidf_(v0[k]) * 255.0f, 1.0f), k, q0); q1 = __builtin_amdgcn_cvt_pk_u8_f32(fmaxf(sigmoidf_(v1[k]) * 255.0f, 1.0f), k, q1); }
                        u32x2 qw; qw.x = q0; qw.y = q1;
                        *(u32x2*)((unsigned char*)base + (size_t)row * ld + colt + bj * 128 + cw) = qw;
                        continue;
                    }
                    u32x4 w; w.x = pk(v0[0], v0[1]); w.y = pk(v0[2], v0[3]); w.z = pk(v1[0], v1[1]); w.w = pk(v1[2], v1[3]);
                    *(u32x4*)(base + (size_t)row * ld + colt + bj * 128 + cw) = w;
                }
                if (kind == 2) {
                    s1 += __shfl_xor(s1, 16); s1 += __shfl_xor(s1, 32); s2 += __shfl_xor(s2, 16); s2 += __shfl_xor(s2, 32);
                    if (fq == 0) { atomicAdd(vstat + 2 * (size_t)row, f2fx(s1)); atomicAdd(vstat + 2 * (size_t)row + 1, f2fx(s2)); }
                }
            }
    }
};
struct EpiRes {
    static constexpr bool PERM = true, AFTER_DRAIN = false, HAS_MID = false, HAS_INIT = true;
    const bf16* xsrc; float* out32; bf16* xb; u64* ssq;
    __device__ __forceinline__ void init(f32x4 (&acc)[2][2][4][2], const pg8::Unit& u, int wr, int wc, int fr, int fq) const {
        const int row0 = u.pm * 256 + wr * 64 + fr, col0 = u.pn * 256 + wc * 32 + 8 * fq;
        u32x4 w[2][4][2];
#pragma unroll
        for (int ai = 0; ai < 2; ++ai)
#pragma unroll
            for (int m = 0; m < 4; ++m)
#pragma unroll
                for (int bj = 0; bj < 2; ++bj) w[ai][m][bj] = *(const u32x4*)(xsrc + (size_t)(row0 + ai * 128 + m * 16) * DM + col0 + bj * 128);
#pragma unroll
        for (int ai = 0; ai < 2; ++ai)
#pragma unroll
            for (int m = 0; m < 4; ++m)
#pragma unroll
                for (int bj = 0; bj < 2; ++bj) { const u32x4 q = w[ai][m][bj]; acc[ai][bj][m][0] = (f32x4){bf_lo(q.x), bf_hi(q.x), bf_lo(q.y), bf_hi(q.y)}; acc[ai][bj][m][1] = (f32x4){bf_lo(q.z), bf_hi(q.z), bf_lo(q.w), bf_hi(q.w)}; }
    }
    __device__ __forceinline__ void operator()(const f32x4 (&acc)[2][2][4][2], const pg8::Unit& u, int wr, int wc, int fr, int fq) const {
        const int row0 = u.pm * 256 + wr * 64 + fr, col0 = u.pn * 256 + wc * 32 + 8 * fq;
#pragma unroll
        for (int ai = 0; ai < 2; ++ai)
#pragma unroll
            for (int m = 0; m < 4; ++m) {
                const int row = row0 + ai * 128 + m * 16; float s = 0.f;
#pragma unroll
                for (int bj = 0; bj < 2; ++bj) {
                    const size_t off = (size_t)row * DM + col0 + bj * 128;
                    const f32x4 o0 = acc[ai][bj][m][0], o1 = acc[ai][bj][m][1];
                    if (out32) { *(f32x4*)(out32 + off) = o0; *(f32x4*)(out32 + off + 4) = o1; }
                    if (xb) { u32x4 w; w.x = pk(o0[0], o0[1]); w.y = pk(o0[2], o0[3]); w.z = pk(o1[0], o1[1]); w.w = pk(o1[2], o1[3]); *(u32x4*)(xb + off) = w; }
                    s += (o0[0] * o0[0] + o0[1] * o0[1]) + (o0[2] * o0[2] + o0[3] * o0[3]) + (o1[0] * o1[0] + o1[1] * o1[1]) + (o1[2] * o1[2] + o1[3] * o1[3]);
                }
                s += __shfl_xor(s, 16); s += __shfl_xor(s, 32);
                if (fq == 0 && ssq) atomicAdd(ssq + row, f2fx(s));
            }
    }
};
struct EpiFF1 {
    static constexpr bool PERM = true, AFTER_DRAIN = false, HAS_MID = false, HAS_INIT = false;
    const u64* ssq; bf16* F;
    __device__ __forceinline__ void operator()(const f32x4 (&acc)[2][2][4][2], const pg8::Unit& u, int wr, int wc, int fr, int fq) const {
        const int row0 = u.pm * 256 + wr * 64 + fr, col0 = u.pn * 256 + wc * 32 + 8 * fq;
#pragma unroll
        for (int ai = 0; ai < 2; ++ai)
#pragma unroll
            for (int m = 0; m < 4; ++m) {
                const int row = row0 + ai * 128 + m * 16;
                const float rs = rsqrtf(fx2f(ssq[row]) * (1.0f / DM) + RMS_EPS);
#pragma unroll
                for (int bj = 0; bj < 2; ++bj) {
                    f32x4 v0 = acc[ai][bj][m][0] * rs, v1 = acc[ai][bj][m][1] * rs;
#pragma unroll
                    for (int k = 0; k < 4; ++k) { const float a = fmaxf(v0[k], 0.f), b = fmaxf(v1[k], 0.f); v0[k] = a * a; v1[k] = b * b; }
                    u32x4 w; w.x = pk(v0[0], v0[1]); w.y = pk(v0[2], v0[3]); w.z = pk(v1[0], v1[1]); w.w = pk(v1[2], v1[3]);
                    *(u32x4*)(F + (size_t)row * FFD + col0 + bj * 128) = w;
                }
            }
    }
};
struct EpiGate {
    static constexpr bool PERM = true, AFTER_DRAIN = false, HAS_MID = true, HAS_INIT = false;
    const bf16 *ga, *gm; bf16* mg;
    __device__ __forceinline__ void mid(f32x4 (&acc)[2][2][4][2], const pg8::Unit& u, int wr, int wc, int fr, int fq) const {
        int row0 = u.pm * 256 + wr * 64 + fr, col0 = u.pn * 256 + wc * 32 + 8 * fq;
        asm volatile("" : "+v"(row0), "+v"(col0));
#pragma unroll
        for (int ai = 0; ai < 2; ++ai) {
            u32x2 w1[4][2], w2[4][2];
#pragma unroll
            for (int m = 0; m < 4; ++m)
#pragma unroll
                for (int bj = 0; bj < 2; ++bj) { const size_t off = (size_t)(row0 + ai * 128 + m * 16) * DM + col0 + bj * 128; w1[m][bj] = *(const u32x2*)((const unsigned char*)ga + off); w2[m][bj] = *(const u32x2*)((const unsigned char*)gm + off); }
#pragma unroll
            for (int m = 0; m < 4; ++m)
#pragma unroll
                for (int bj = 0; bj < 2; ++bj) {
                    float g1[8], g2[8]; unpack8u(w1[m][bj], g1); unpack8u(w2[m][bj], g2);
#pragma unroll
                    for (int k = 0; k < 4; ++k) { acc[ai][bj][m][0][k] *= g1[k] * __builtin_amdgcn_rcpf(fmaxf(g2[k], 1e-30f)); acc[ai][bj][m][1][k] *= g1[4 + k] * __builtin_amdgcn_rcpf(fmaxf(g2[4 + k], 1e-30f)); }
                }
            __builtin_amdgcn_sched_barrier(0);
        }
    }
    __device__ __forceinline__ void operator()(const f32x4 (&acc)[2][2][4][2], const pg8::Unit& u, int wr, int wc, int fr, int fq) const {
        const int row0 = u.pm * 256 + wr * 64 + fr, col0 = u.pn * 256 + wc * 32 + 8 * fq;
#pragma unroll
        for (int ai = 0; ai < 2; ++ai)
#pragma unroll
            for (int m = 0; m < 4; ++m) {
                const int row = row0 + ai * 128 + m * 16;
#pragma unroll
                for (int bj = 0; bj < 2; ++bj) {
                    const size_t off = (size_t)row * DM + col0 + bj * 128;
                    float g2[8]; unpack8u(*(const u32x2*)((const unsigned char*)gm + off), g2);
#pragma unroll
                    for (int k = 0; k < 8; ++k) g2[k] *= (1.0f / 255.0f);
                    const f32x4 v0 = acc[ai][bj][m][0], v1 = acc[ai][bj][m][1];
                    u32x4 w; w.x = pk(v0[0] * g2[0], v0[1] * g2[1]); w.y = pk(v0[2] * g2[2], v0[3] * g2[3]); w.z = pk(v1[0] * g2[4], v1[1] * g2[5]); w.w = pk(v1[2] * g2[6], v1[3] * g2[7]);
                    *(u32x4*)(mg + off) = w;
                }
            }
    }
};

struct MiniOrder {
    int c0, ntile, S, kchunk, c;
    __device__ __forceinline__ bool next(int i, pg8::Unit& u) const { const int j = c - c0; if (i != 0 || j < 0 || j >= ntile * S) return false; u.pm = NPT / 256; u.pn = j / S; u.ks = j % S; u.k0 = u.ks * kchunk; return true; }
    __device__ __forceinline__ void a_ready(const pg8::Unit&) const {}
    __device__ __forceinline__ void done(const pg8::Unit&) const {}
};
struct EpiPart {
    static constexpr bool PERM = true, AFTER_DRAIN = false, HAS_MID = false, HAS_INIT = false;
    float* part; int slots, slot0;
    __device__ __forceinline__ void operator()(const f32x4 (&acc)[2][2][4][2], const pg8::Unit& u, int wr, int wc, int fr, int fq) const {
        bf16* pt = (bf16*)part + (size_t)(u.pn * slots + slot0 + u.ks) * 65536;
#pragma unroll
        for (int ai = 0; ai < 2; ++ai)
#pragma unroll
            for (int m = 0; m < 4; ++m)
#pragma unroll
                for (int bj = 0; bj < 2; ++bj) { const f32x4 v0 = acc[ai][bj][m][0], v1 = acc[ai][bj][m][1];
                    u32x4 w; w.x = pk(v0[0], v0[1]); w.y = pk(v0[2], v0[3]); w.z = pk(v1[0], v1[1]); w.w = pk(v1[2], v1[3]);
                    *(u32x4*)(pt + (ai * 128 + wr * 64 + m * 16 + fr) * 256 + bj * 128 + wc * 32 + 8 * fq) = w; }
    }
};
__device__ __forceinline__ f32x4 ld_part4(const bf16* p) { const u32x2 w = *(const u32x2*)p; return (f32x4){bf_lo(w.x), bf_hi(w.x), bf_lo(w.y), bf_hi(w.y)}; }
__device__ __forceinline__ void st_wt8(void* p, unsigned lo, unsigned hi) { __hip_atomic_store((u64*)p, ((u64)hi << 32) | (u64)lo, __ATOMIC_RELAXED, __HIP_MEMORY_SCOPE_AGENT); }
template <int S> __device__ __forceinline__ void fixup_res(const float* part, const bf16* xsrc, float* out32, bf16* xb, u64* ssq, int gw, int NGW, int lane) {
    for (int it = gw; it < 8 * 256; it += NGW) { const int pn = it >> 8, r = it & 255;
        const bf16* pp = (const bf16*)part + (size_t)(pn * S) * 65536 + r * 256 + 4 * lane;
        f32x4 v[S];
#pragma unroll
        for (int sp = 0; sp < S; ++sp) v[sp] = ld_part4(pp + (size_t)sp * 65536);
        f32x4 a = v[0];
#pragma unroll
        for (int sp = 1; sp < S; ++sp) a += v[sp];
        const size_t off = (size_t)(NPT + r) * DM + pn * 256 + 4 * lane;
        const f32x4 o = ld_part4(xsrc + off) + a;
        if (out32) *(f32x4*)(out32 + off) = o;
        if (xb) st_wt8(xb + off, pk(o[0], o[1]), pk(o[2], o[3]));
        const float sq = wave_sum((o[0] * o[0] + o[1] * o[1]) + (o[2] * o[2] + o[3] * o[3]));
        if (lane == 0 && ssq) atomicAdd(ssq + NPT + r, f2fx(sq)); }
}
template <int S> __device__ __forceinline__ void fixup_ff1(const float* part, const u64* ssq, bf16* F, int gw, int NGW, int lane) {
    for (int it = gw; it < 32 * 256; it += 2 * NGW) {
        const int it2 = (it + NGW < 32 * 256) ? it + NGW : it;
        const int pn = it >> 8, r = it & 255, pn2 = it2 >> 8, r2 = it2 & 255;
        const bf16* pp = (const bf16*)part + (size_t)(pn * S) * 65536 + r * 256 + 4 * lane;
        const bf16* pq = (const bf16*)part + (size_t)(pn2 * S) * 65536 + r2 * 256 + 4 * lane;
        f32x4 v[S], w2[S];
#pragma unroll
        for (int sp = 0; sp < S; ++sp) { v[sp] = ld_part4(pp + (size_t)sp * 65536); w2[sp] = ld_part4(pq + (size_t)sp * 65536); }
        const float rs = rsqrtf(fx2f(ssq[NPT + r]) * (1.0f / DM) + RMS_EPS), rs2 = rsqrtf(fx2f(ssq[NPT + r2]) * (1.0f / DM) + RMS_EPS);
        f32x4 a = v[0], c = w2[0];
#pragma unroll
        for (int sp = 1; sp < S; ++sp) { a += v[sp]; c += w2[sp]; }
#pragma unroll
        for (int k = 0; k < 4; ++k) { const float t = fmaxf(a[k] * rs, 0.f); a[k] = t * t; const float u = fmaxf(c[k] * rs2, 0.f); c[k] = u * u; }
        st_wt8(F + (size_t)(NPT + r) * FFD + pn * 256 + 4 * lane, pk(a[0], a[1]), pk(a[2], a[3]));
        st_wt8(F + (size_t)(NPT + r2) * FFD + pn2 * 256 + 4 * lane, pk(c[0], c[1]), pk(c[2], c[3]));
    }
}
template <int S> __device__ __forceinline__ void fixup_merge(const float* part, const bf16* ga, const bf16* gm, bf16* mg, int gw, int NGW, int lane) {
    for (int it = gw; it < 8 * 256; it += NGW) { const int pn = it >> 8, r = it & 255;
        const bf16* pp = (const bf16*)part + (size_t)(pn * 2 * S) * 65536 + r * 256 + 4 * lane;
        f32x4 v[2 * S];
#pragma unroll
        for (int sp = 0; sp < 2 * S; ++sp) v[sp] = ld_part4(pp + (size_t)sp * 65536);
        f32x4 a = v[0], b = v[S];
#pragma unroll
        for (int sp = 1; sp < S; ++sp) { a += v[sp]; b += v[S + sp]; }
        const size_t off = (size_t)(NPT + r) * DM + pn * 256 + 4 * lane;
        const unsigned b1 = *(const unsigned*)((const unsigned char*)ga + off), b2 = *(const unsigned*)((const unsigned char*)gm + off);
        float o[4];
#pragma unroll
        for (int k = 0; k < 4; ++k) o[k] = ((float)((b1 >> (8 * k)) & 0xffu) * a[k] + (float)((b2 >> (8 * k)) & 0xffu) * b[k]) * (1.0f / 255.0f);
        st_wt8(mg + off, pk(o[0], o[1]), pk(o[2], o[3])); }
}
__device__ __forceinline__ int tid_now() { int t = threadIdx.x; asm volatile("" : "+v"(t)); return t; }
__device__ __forceinline__ void split_arrive(unsigned* ctr) {
    asm volatile("s_waitcnt vmcnt(0)" ::: "memory");
    __syncthreads();
    if (tid_now() == 0) (void)__hip_atomic_fetch_add(ctr, 1u, __ATOMIC_RELAXED, __HIP_MEMORY_SCOPE_AGENT);
}
__device__ __forceinline__ void split_wait(unsigned* ctr, unsigned G) {
    if (tid_now() == 0) { while (__hip_atomic_load(ctr, __ATOMIC_RELAXED, __HIP_MEMORY_SCOPE_AGENT) < G) __builtin_amdgcn_s_sleep(2);
        asm volatile("s_waitcnt vmcnt(0)" ::: "memory"); }
    __syncthreads();
}

__device__ __forceinline__ void p0_transpose_item(const float* W, const float* gk, int K, int N, bf16* WT, LAS float* scr, int item, int lane) {
    const int nblk = N / 64, kb = item / nblk, nb = item - kb * nblk, k0 = 64 * kb, n0 = 64 * nb;
    const int r4 = lane >> 4, c4 = (lane & 15) * 4;
    f32x4 v[16];
#pragma unroll
    for (int i = 0; i < 16; ++i) v[i] = __builtin_nontemporal_load((const f32x4*)(W + (size_t)(k0 + r4 + 4 * i) * N + n0 + c4));
    if (gk) {
#pragma unroll
        for (int i = 0; i < 16; ++i) v[i] *= gk[k0 + r4 + 4 * i];
    }
#pragma unroll
    for (int i = 0; i < 16; ++i) { LAS float* d = scr + (r4 + 4 * i) * 65 + c4; d[0] = v[i][0]; d[1] = v[i][1]; d[2] = v[i][2]; d[3] = v[i][3]; }
    asm volatile("s_waitcnt lgkmcnt(0)" ::: "memory");
    const int c = lane & 7;
#pragma unroll
    for (int j = 0; j < 8; ++j) { const int n = (lane >> 3) + 8 * j; const LAS float* s = scr + (8 * c) * 65 + n;
        u32x4 o; o.x = pk(s[0 * 65], s[1 * 65]); o.y = pk(s[2 * 65], s[3 * 65]); o.z = pk(s[4 * 65], s[5 * 65]); o.w = pk(s[6 * 65], s[7 * 65]);
        *(u32x4*)(WT + (size_t)(n0 + n) * K + k0 + 8 * c) = o; }
    asm volatile("s_waitcnt lgkmcnt(0)" ::: "memory");
}
__device__ __forceinline__ void phase0(const Params& p, LAS unsigned char* lds, int G, int bid, int tid, int wave, int lane) {
    LAS float* scr = (LAS float*)(lds + wave * 16640);
    const int gw = bid * 8 + wave, NGW = G * 8;
    constexpr int I_IN = (DM / 64) * (INC / 64), I_AU = (AW / 64) * (DM / 64), I_OUT = (DM / 64) * (DM / 64), I_1 = (DM / 64) * (FFD / 64), I_2 = (FFD / 64) * (DM / 64);
    constexpr int I_L = I_IN + 2 * I_AU + I_OUT + I_1 + I_2;
    for (int it = gw; it < NLAYER * I_L; it += NGW) {
        const int lq = it / I_L, l = NLAYER - 1 - lq; int r = it - lq * I_L;
        if (r < I_IN) { p0_transpose_item(p.w_in + (size_t)l * DM * INC, p.norm1_g + l * DM, DM, INC, (bf16*)(p.ws + WS_WIN) + (size_t)l * INC * DM, scr, r, lane); continue; } r -= I_IN;
        if (r < I_AU) { p0_transpose_item(p.w_au + (size_t)l * AW * DM, nullptr, 2 * AW, DM, (bf16*)(p.ws + WS_WAU) + (size_t)l * DM * 2 * AW, scr, r, lane); continue; } r -= I_AU;
        if (r < I_AU) { p0_transpose_item(p.w_su + (size_t)l * AW * DM, nullptr, 2 * AW, DM, (bf16*)(p.ws + WS_WAU) + (size_t)l * DM * 2 * AW + AW, scr, r, lane); continue; } r -= I_AU;
        if (r < I_OUT) { p0_transpose_item(p.w_out + (size_t)l * DM * DM, nullptr, DM, DM, (bf16*)(p.ws + WS_WOUT) + (size_t)l * DM * DM, scr, r, lane); continue; } r -= I_OUT;
        if (r < I_1) { p0_transpose_item(p.w_ff1 + (size_t)l * DM * FFD, p.norm2_g + l * DM, DM, FFD, (bf16*)(p.ws + WS_W1) + (size_t)l * FFD * DM, scr, r, lane); continue; } r -= I_1;
        p0_transpose_item(p.w_ff2 + (size_t)l * FFD * DM, nullptr, FFD, DM, (bf16*)(p.ws + WS_W2) + (size_t)l * DM * FFD, scr, r, lane);
    }
    u64* st = (u64*)(p.ws + WS_STAT);
    bf16* XB = (bf16*)(p.ws + WS_XB);
    for (int m = gw; m < MTOK; m += NGW) {
        const float* xr = m < NPT ? p.x_prompt + (size_t)m * DM : p.x_sample + (size_t)(m - NPT) * DM;
        f32x4 v[8]; float s = 0.f;
#pragma unroll
        for (int j = 0; j < 8; ++j) { v[j] = ((const f32x4*)xr)[lane + 64 * j]; s += (v[j][0] * v[j][0] + v[j][1] * v[j][1]) + (v[j][2] * v[j][2] + v[j][3] * v[j][3]); }
        s = wave_sum(s);
#pragma unroll
        for (int j = 0; j < 8; ++j) { u32x2 w; w.x = pk(v[j][0], v[j][1]); w.y = pk(v[j][2], v[j][3]); ((u32x2*)(XB + (size_t)m * DM))[lane + 64 * j] = w; }
        if (lane == 0) st[m] = f2fx(s);
    }
    for (int i = bid * 512 + tid; i < 16 * MTOK; i += G * 512) if (i >= MTOK) st[i] = 0ull;
}

constexpr int KS_LD = 72, VT_LD = 260, VT_OFF = 256 * KS_LD * 2;
__device__ __forceinline__ void rope_cs(float pos, int fi, float& c, float& s) {
    const float inv = __builtin_amdgcn_exp2f(-(float)fi * (13.287712379549449f / 32.0f));
    const float ang = pos * inv;
    const float n = rintf(ang * 0.15915494309189535f);
    float r = fmaf(-n, 6.2831854820251465f, ang);
    r = fmaf(n, 1.7484555e-7f, r);
    s = __sinf(r); c = __cosf(r);
}
__device__ __forceinline__ void stage_k_row(const bf16* kraw, bool valid, float pos, int sub, const float* kg, LAS bf16* ksrow, float* kout) {
    u32x4 a0 = {0u, 0u, 0u, 0u}, a1 = a0, b0 = a0, b1 = a0;
    if (valid) { const u32x4* s = (const u32x4*)(kraw + 16 * sub); a0 = s[0]; a1 = s[1]; const u32x4* t = (const u32x4*)(kraw + 32 + 16 * sub); b0 = t[0]; b1 = t[1]; }
    float x1[16], x2[16];
    unpack8(a0, x1); unpack8(a1, x1 + 8); unpack8(b0, x2); unpack8(b1, x2 + 8);
    float ss = 0.f;
#pragma unroll
    for (int i = 0; i < 16; ++i) ss += x1[i] * x1[i] + x2[i] * x2[i];
    ss += __shfl_xor(ss, 1);
    const float rstd = rsqrtf(ss * (1.0f / 64.0f) + RMS_EPS);
    float o1[16], o2[16];
#pragma unroll
    for (int i = 0; i < 16; ++i) { const int fi = 16 * sub + i; float c, s; rope_cs(pos, fi, c, s);
        const float y1 = x1[i] * rstd * kg[fi], y2 = x2[i] * rstd * kg[32 + fi]; o1[i] = y1 * c - y2 * s; o2[i] = y2 * c + y1 * s; }
    *(LAS u32x4*)(ksrow + 16 * sub) = pack8(o1); *(LAS u32x4*)(ksrow + 16 * sub + 8) = pack8(o1 + 8);
    *(LAS u32x4*)(ksrow + 32 + 16 * sub) = pack8(o2); *(LAS u32x4*)(ksrow + 32 + 16 * sub + 8) = pack8(o2 + 8);
    if (kout != nullptr && valid) {
#pragma unroll
        for (int i = 0; i < 4; ++i) { ((f32x4*)(kout + 16 * sub))[i] = (f32x4){o1[4 * i], o1[4 * i + 1], o1[4 * i + 2], o1[4 * i + 3]};
            ((f32x4*)(kout + 32 + 16 * sub))[i] = (f32x4){o2[4 * i], o2[4 * i + 1], o2[4 * i + 2], o2[4 * i + 3]}; }
    }
}
__device__ __forceinline__ void q_frag_from_raw(const u32x4 a, const u32x4 b, float pos, int g, const float* qg, bf16x8& qf0, bf16x8& qf1) {
    float x1[8], x2[8]; unpack8(a, x1); unpack8(b, x2);
    float ss = 0.f;
#pragma unroll
    for (int i = 0; i < 8; ++i) ss += x1[i] * x1[i] + x2[i] * x2[i];
    ss += __shfl_xor(ss, 16); ss += __shfl_xor(ss, 32);
    const float rstd = rsqrtf(ss * (1.0f / 64.0f) + RMS_EPS) * (0.125f * 1.4426950408889634f);
    float o1[8], o2[8];
#pragma unroll
    for (int i = 0; i < 8; ++i) { const int fi = 8 * g + i; float c, s; rope_cs(pos, fi, c, s);
        const float y1 = x1[i] * rstd * qg[fi], y2 = x2[i] * rstd * qg[32 + fi]; o1[i] = y1 * c - y2 * s; o2[i] = y2 * c + y1 * s; }
    qf0 = __builtin_bit_cast(bf16x8, pack8(o1)); qf1 = __builtin_bit_cast(bf16x8, pack8(o2));
}
__device__ __forceinline__ void load_q_frag(const bf16* qraw, float pos, int g, const float* qg, bf16x8& qf0, bf16x8& qf1) {
    const u32x4 a = *(const u32x4*)(qraw + 8 * g), b = *(const u32x4*)(qraw + 32 + 8 * g);
    q_frag_from_raw(a, b, pos, g, qg, qf0, qf1);
}
template <int PAR> __device__ __forceinline__ void attn_group(const LAS bf16* KS, const LAS bf16* VT, bf16x8 qf0, bf16x8 qf1, int c0, int qrel, int rmin, float sink2, bf16* orow, int lane) {
    const int r16 = lane & 15, g = lane >> 4, d = 4 * g - qrel;
    f32x4 sc[10];
    float mx = sink2;
#pragma unroll
    for (int tt = 0; tt < 10; ++tt) {
        constexpr int dummy = 0; (void)dummy;
        const int r = tt - PAR;
        if (r < 0 || r > 8) { sc[tt] = (f32x4){0.f, 0.f, 0.f, 0.f}; continue; }
        const LAS bf16* kp = KS + (32 * c0 + 16 * tt + r16) * KS_LD + 8 * g;
        const bf16x8 k0 = *(const LAS bf16x8*)kp, k1 = *(const LAS bf16x8*)(kp + 32);
        f32x4 a = {0.f, 0.f, 0.f, 0.f};
        a = __builtin_amdgcn_mfma_f32_16x16x32_bf16(k0, qf0, a, 0, 0, 0);
        a = __builtin_amdgcn_mfma_f32_16x16x32_bf16(k1, qf1, a, 0, 0, 0);
        if (r < rmin) a = (f32x4){-1e30f, -1e30f, -1e30f, -1e30f};
        else if (r == 0) {
#pragma unroll
            for (int q = 0; q < 4; ++q) a[q] = (d + q > 0) ? a[q] : -1e30f;
        } else if (r == 8) {
#pragma unroll
            for (int q = 0; q < 4; ++q) a[q] = (d + q <= 0) ? a[q] : -1e30f;
        }
        sc[tt] = a;
        mx = fmaxf(fmaxf(mx, fmaxf(a[0], a[1])), fmaxf(a[2], a[3]));
    }
    mx = fmaxf(mx, __shfl_xor(mx, 16)); mx = fmaxf(mx, __shfl_xor(mx, 32));
    float sum = 0.f;
#pragma unroll
    for (int tt = 0; tt < 10; ++tt) {
        const int r = tt - PAR;
        if (r < 0 || r > 8) continue;
#pragma unroll
        for (int q = 0; q < 4; ++q) { const float pz = __builtin_amdgcn_exp2f(sc[tt][q] - mx); sc[tt][q] = pz; sum += pz; }
    }
    sum += __shfl_xor(sum, 16); sum += __shfl_xor(sum, 32);
    const float inv = 1.0f / (sum + __builtin_amdgcn_exp2f(sink2 - mx));
    f32x4 o[4];
#pragma unroll
    for (int dt = 0; dt < 4; ++dt) o[dt] = (f32x4){0.f, 0.f, 0.f, 0.f};
#pragma unroll
    for (int cc = 0; cc < 5; ++cc) {
        u32x4 pw; pw.x = pk(sc[2 * cc][0], sc[2 * cc][1]); pw.y = pk(sc[2 * cc][2], sc[2 * cc][3]); pw.z = pk(sc[2 * cc + 1][0], sc[2 * cc + 1][1]); pw.w = pk(sc[2 * cc + 1][2], sc[2 * cc + 1][3]);
        const bf16x8 pf = __builtin_bit_cast(bf16x8, pw);
#pragma unroll
        for (int dt = 0; dt < 4; ++dt) {
            const LAS bf16* vp = VT + (16 * dt + r16) * VT_LD + 32 * (c0 + cc) + 4 * g;
            const u32x2 lo = *(const LAS u32x2*)vp, hi = *(const LAS u32x2*)(vp + 16);
            u32x4 vw; vw.x = lo.x; vw.y = lo.y; vw.z = hi.x; vw.w = hi.y;
            o[dt] = __builtin_amdgcn_mfma_f32_16x16x32_bf16(__builtin_bit_cast(bf16x8, vw), pf, o[dt], 0, 0, 0);
        }
    }
#pragma unroll
    for (int dt = 0; dt < 4; ++dt) { const f32x4 v = o[dt] * inv; u32x2 w; w.x = pk(v[0], v[1]); w.y = pk(v[2], v[3]); *(u32x2*)(orow + 16 * dt + 4 * g) = w; }
}
template <int PAR> __device__ __forceinline__ void attn_prompt_wave(const LAS bf16* KS, const LAS bf16* VT, const u32x4 (&qa)[4], const u32x4 (&qbw)[4], const float* qg, const float* sinks, int kvh, int qb, int wave, bf16* orow0, int lane) {
    const int g = lane >> 4, tokq = qb * 128 + 16 * wave + (lane & 15);
    float cs[8], sn[8], g1[8], g2[8];
#pragma unroll
    for (int i = 0; i < 8; ++i) { rope_cs((float)tokq, 8 * g + i, cs[i], sn[i]); g1[i] = qg[8 * g + i]; g2[i] = qg[32 + 8 * g + i]; }
#pragma unroll
    for (int hg = 0; hg < 4; ++hg) {
        float x1[8], x2[8]; unpack8(qa[hg], x1); unpack8(qbw[hg], x2);
        float ss = 0.f;
#pragma unroll
        for (int i = 0; i < 8; ++i) ss += x1[i] * x1[i] + x2[i] * x2[i];
        ss += __shfl_xor(ss, 16); ss += __shfl_xor(ss, 32);
        const float rstd = rsqrtf(ss * (1.0f / 64.0f) + RMS_EPS) * (0.125f * 1.4426950408889634f);
        float o1[8], o2[8];
#pragma unroll
        for (int i = 0; i < 8; ++i) { const float y1 = x1[i] * rstd * g1[i], y2 = x2[i] * rstd * g2[i]; o1[i] = y1 * cs[i] - y2 * sn[i]; o2[i] = y2 * cs[i] + y1 * sn[i]; }
        const bf16x8 qf0 = __builtin_bit_cast(bf16x8, pack8(o1)), qf1 = __builtin_bit_cast(bf16x8, pack8(o2));
        attn_group<PAR>(KS, VT, qf0, qf1, wave >> 1, lane & 15, qb > 0 ? 0 : 8 - wave, sinks[kvh * 4 + hg] * 1.4426950408889634f, orow0 + hg * 64, lane);
    }
}
__device__ __forceinline__ void attn_prompt_unit(const Params& p, int l, int unit, LAS unsigned char* lds, int tid, int wave, int lane) {
    asm volatile("" : "+v"(tid), "+v"(lane));
    const int b = unit >> 7, qb = (unit >> 2) & 31, kvh = unit & 3;
    LAS bf16* KS = (LAS bf16*)lds; LAS bf16* VT = (LAS bf16*)(lds + VT_OFF);
    const bf16* QKV = (const bf16*)(p.ws + WS_QKV); bf16* AO = (bf16*)(p.ws + WS_AO);
    const float* kg = p.k_norm_g + l * 64; const float* qg = p.q_norm_g + l * 64;
    const size_t qrow = (size_t)b * SEQ + qb * 128 + 16 * wave + (lane & 15);
    u32x4 qa[4], qbw[4];
#pragma unroll
    for (int hg = 0; hg < 4; ++hg) { const bf16* qraw = QKV + qrow * QKVW + (kvh * 4 + hg) * 64; qa[hg] = *(const u32x4*)(qraw + 8 * (lane >> 4)); qbw[hg] = *(const u32x4*)(qraw + 32 + 8 * (lane >> 4)); }
    u32x4 vw[4];
#pragma unroll
    for (int i = 0; i < 4; ++i) { const int c = tid + 512 * i, key = c >> 3, dch = c & 7, tok = qb * 128 - 128 + key;
        vw[i] = (u32x4){0u, 0u, 0u, 0u};
        if (tok >= 0) vw[i] = *(const u32x4*)(QKV + (size_t)(b * SEQ + tok) * QKVW + 1280 + kvh * 64 + 8 * dch); }
    { const int key = tid >> 1, sub = tid & 1, tok = qb * 128 - 128 + key; const bool valid = tok >= 0;
      const bf16* kraw = QKV + (size_t)(b * SEQ + (valid ? tok : 0)) * QKVW + 1024 + kvh * 64;
      float* kout = (qb == 31 && key >= 128) ? p.out + O_KP + ((size_t)((l * 2 + b) * 128 + (key - 128)) * 4 + kvh) * 64 : nullptr;
      stage_k_row(kraw, valid, (float)tok, sub, kg, KS + key * KS_LD, kout); }
#pragma unroll
    for (int i = 0; i < 4; ++i) {
        const int c = tid + 512 * i, key = c >> 3, dch = c & 7; const u32x4 w = vw[i];
        LAS bf16* vp = VT + (8 * dch) * VT_LD + key;
        vp[0] = (bf16)(w.x & 0xffffu); vp[VT_LD] = (bf16)(w.x >> 16); vp[2 * VT_LD] = (bf16)(w.y & 0xffffu); vp[3 * VT_LD] = (bf16)(w.y >> 16);
        vp[4 * VT_LD] = (bf16)(w.z & 0xffffu); vp[5 * VT_LD] = (bf16)(w.z >> 16); vp[6 * VT_LD] = (bf16)(w.w & 0xffffu); vp[7 * VT_LD] = (bf16)(w.w >> 16);
        if (qb == 31 && key >= 128) { float f[8]; unpack8(w, f); float* vo = p.out + O_VP + ((size_t)((l * 2 + b) * 128 + (key - 128)) * 4 + kvh) * 64 + 8 * dch;
            *(f32x4*)vo = (f32x4){f[0], f[1], f[2], f[3]}; *(f32x4*)(vo + 4) = (f32x4){f[4], f[5], f[6], f[7]}; }
    }
    __syncthreads();
    bf16* orow0 = AO + qrow * (2 * AW) + kvh * 256;
    if (wave & 1) attn_prompt_wave<1>(KS, VT, qa, qbw, qg, p.sinks + l * 16, kvh, qb, wave, orow0, lane);
    else attn_prompt_wave<0>(KS, VT, qa, qbw, qg, p.sinks + l * 16, kvh, qb, wave, orow0, lane);
}
__device__ __forceinline__ void attn_sample_unit(const Params& p, int l, int unit, LAS unsigned char* lds, int tid, int wave, int lane) {
    asm volatile("" : "+v"(tid), "+v"(lane));
    const int s = unit >> 2, kvh = unit & 3;
    LAS bf16* KS = (LAS bf16*)lds; LAS bf16* VT = (LAS bf16*)(lds + VT_OFF);
    const bf16* QKV = (const bf16*)(p.ws + WS_QKV); bf16* AO = (bf16*)(p.ws + WS_AO);
    const float* kg = p.k_norm_g + l * 64; const float* qg = p.q_norm_g + l * 64;
    const size_t cbase = ((size_t)l * 32 + s) * 128;
    const int qn = lane & 15, qt = qn & 7, qhead = kvh * 4 + 2 * (wave & 1) + (qn >> 3); const size_t qrow = (size_t)NPT + s * 8 + qt;
    const u32x4 qra = *(const u32x4*)(QKV + qrow * QKVW + qhead * 64 + 8 * (lane >> 4)), qrb = *(const u32x4*)(QKV + qrow * QKVW + qhead * 64 + 32 + 8 * (lane >> 4));
    const float qsink = p.sinks[l * 16 + qhead];
    { const int key = tid >> 2, dq = tid & 3; const float* src = p.cache_k + ((cbase + key) * 4 + kvh) * 64 + 16 * dq;
      f32x4 a[4];
#pragma unroll
      for (int i = 0; i < 4; ++i) a[i] = ((const f32x4*)src)[i];
      u32x4 w0, w1; w0.x = pk(a[0][0], a[0][1]); w0.y = pk(a[0][2], a[0][3]); w0.z = pk(a[1][0], a[1][1]); w0.w = pk(a[1][2], a[1][3]);
      w1.x = pk(a[2][0], a[2][1]); w1.y = pk(a[2][2], a[2][3]); w1.z = pk(a[3][0], a[3][1]); w1.w = pk(a[3][2], a[3][3]);
      *(LAS u32x4*)(KS + key * KS_LD + 16 * dq) = w0; *(LAS u32x4*)(KS + key * KS_LD + 16 * dq + 8) = w1;
      if (key >= 8) { float* dst = p.out + O_KS + ((cbase + key - 8) * 4 + kvh) * 64 + 16 * dq;
#pragma unroll
          for (int i = 0; i < 4; ++i) ((f32x4*)dst)[i] = a[i]; } }
    if (tid < 16) { const int t = tid >> 1, sub = tid & 1;
        stage_k_row(QKV + (size_t)(NPT + s * 8 + t) * QKVW + 1024 + kvh * 64, true, (float)(16384 + t), sub, kg, KS + (128 + t) * KS_LD, p.out + O_KS + ((cbase + 120 + t) * 4 + kvh) * 64); }
    if (tid >= 64 && tid < 64 + 96) { const int idx = tid - 64, rowk = 136 + (idx >> 2), dq = idx & 3; const u32x4 z = {0u, 0u, 0u, 0u};
        *(LAS u32x4*)(KS + rowk * KS_LD + 16 * dq) = z; *(LAS u32x4*)(KS + rowk * KS_LD + 16 * dq + 8) = z; }
#pragma unroll
    for (int i = 0; i < 4; ++i) {
        const int c = tid + 512 * i, key = c >> 4, dq = c & 15;
        const f32x4 a = *(const f32x4*)(p.cache_v + ((cbase + key) * 4 + kvh) * 64 + 4 * dq);
        const unsigned w0 = pk(a[0], a[1]), w1 = pk(a[2], a[3]);
        LAS bf16* vp = VT + (4 * dq) * VT_LD + key;
        vp[0] = (bf16)(w0 & 0xffffu); vp[VT_LD] = (bf16)(w0 >> 16); vp[2 * VT_LD] = (bf16)(w1 & 0xffffu); vp[3 * VT_LD] = (bf16)(w1 >> 16);
        if (key >= 8) *(f32x4*)(p.out + O_VSAMP + ((cbase + key - 8) * 4 + kvh) * 64 + 4 * dq) = a;
    }
    if (tid < 64) { const int t = tid >> 3, dch = tid & 7;
        const u32x4 w = *(const u32x4*)(QKV + (size_t)(NPT + s * 8 + t) * QKVW + 1280 + kvh * 64 + 8 * dch);
        LAS bf16* vp = VT + (8 * dch) * VT_LD + 128 + t;
        vp[0] = (bf16)(w.x & 0xffffu); vp[VT_LD] = (bf16)(w.x >> 16); vp[2 * VT_LD] = (bf16)(w.y & 0xffffu); vp[3 * VT_LD] = (bf16)(w.y >> 16);
        vp[4 * VT_LD] = (bf16)(w.z & 0xffffu); vp[5 * VT_LD] = (bf16)(w.z >> 16); vp[6 * VT_LD] = (bf16)(w.w & 0xffffu); vp[7 * VT_LD] = (bf16)(w.w >> 16);
        float f[8]; unpack8(w, f); float* vo = p.out + O_VSAMP + ((cbase + 120 + t) * 4 + kvh) * 64 + 8 * dch;
        *(f32x4*)vo = (f32x4){f[0], f[1], f[2], f[3]}; *(f32x4*)(vo + 4) = (f32x4){f[4], f[5], f[6], f[7]};
    } else if (tid < 128) { const int d = tid - 64; LAS unsigned* zp = (LAS unsigned*)(VT + d * VT_LD + 136);
#pragma unroll
        for (int i = 0; i < 12; ++i) zp[i] = 0u; }
    __syncthreads();
    if (wave < 2) {
        bf16x8 qf0, qf1; q_frag_from_raw(qra, qrb, (float)(16384 + qt), lane >> 4, qg, qf0, qf1);
        attn_group<0>(KS, VT, qf0, qf1, 0, qt, 0, qsink * 1.4426950408889634f, AO + qrow * (2 * AW) + qhead * 64, lane);
    }
}
constexpr int SG_LD = 136, SG_WOFF = 128 * SG_LD * 2;
__device__ __forceinline__ void sgu_prompt_unit(const Params& p, int l, int unit, LAS unsigned char* lds, int tid, int wave, int lane, bool stage_w) {
    asm volatile("" : "+v"(tid), "+v"(lane));
    const int b = unit >> 8, n = (unit >> 3) & 31, grp = unit & 7;
    LAS bf16* VNT = (LAS bf16*)lds; LAS bf16* WL = (LAS bf16*)(lds + SG_WOFF);
    const bf16* VS = (const bf16*)(p.ws + WS_VS); const bf16* U = (const bf16*)(p.ws + WS_U); bf16* MO = (bf16*)(p.ws + WS_AO) + AW;
    const u64* vst = (const u64*)(p.ws + WS_STAT) + 8 * MTOK + (size_t)l * 2 * MTOK;
    const size_t row0 = (size_t)b * SEQ + n * 128;
    u32x2 upre[8];
#pragma unroll
    for (int ct = 0; ct < 8; ++ct) upre[ct] = *(const u32x2*)(U + (row0 + 16 * wave + (lane & 15)) * 1024 + grp * 128 + 16 * ct + 4 * (lane >> 4));
    if (stage_w) { const int t = tid >> 2, q4 = tid & 3; const float* src = p.sgu_w + (((size_t)l * 8 + grp) * 128 + t) * 128 + 32 * q4;
#pragma unroll
      for (int k = 0; k < 4; ++k) { const f32x4 a = ((const f32x4*)src)[2 * k], bb = ((const f32x4*)src)[2 * k + 1]; const int s0 = 32 * q4 + 8 * k; float f[8];
#pragma unroll
          for (int i = 0; i < 4; ++i) { f[i] = (s0 + i <= t) ? a[i] : 0.f; f[4 + i] = (s0 + 4 + i <= t) ? bb[i] : 0.f; }
          *(LAS u32x4*)(WL + t * SG_LD + s0) = pack8(f); } }
#pragma unroll
    for (int i = 0; i < 4; ++i) {
        const int c = tid + 512 * i, sr = c >> 4, cch = c & 15; const size_t row = row0 + sr;
        const u32x4 w = *(const u32x4*)(VS + row * 1024 + grp * 128 + 8 * cch);
        const float s1 = fx2f(vst[2 * row]), s2 = fx2f(vst[2 * row + 1]), mean = s1 * (1.0f / 1024.0f), var = s2 * (1.0f / 1024.0f) - mean * mean, rstd = rsqrtf(var + LN_EPS);
        const float* gp = p.ln_g + l * 1024 + grp * 128 + 8 * cch; const float* bp = p.ln_b + l * 1024 + grp * 128 + 8 * cch;
        const f32x4 g0 = *(const f32x4*)gp, g1 = *(const f32x4*)(gp + 4), b0 = *(const f32x4*)bp, b1 = *(const f32x4*)(bp + 4);
        float x[8]; unpack8(w, x);
        LAS bf16* vp = VNT + (8 * cch) * SG_LD + (((sr >> 3) ^ cch) << 3) + (sr & 7);
#pragma unroll
        for (int k = 0; k < 4; ++k) { const float v0 = (x[k] - mean) * rstd * g0[k] + b0[k], v1 = (x[4 + k] - mean) * rstd * g1[k] + b1[k];
            vp[k * SG_LD] = (bf16)(pk(v0, 0.f) & 0xffffu); vp[(4 + k) * SG_LD] = (bf16)(pk(v1, 0.f) & 0xffffu); }
    }
    __syncthreads();
    const int t0 = 16 * wave, r16 = lane & 15, g = lane >> 4;
    f32x4 acc[8];
#pragma unroll
    for (int ct = 0; ct < 8; ++ct) acc[ct] = (f32x4){0.f, 0.f, 0.f, 0.f};
    const int nks = (wave >> 1) + 1;
    for (int ks = 0; ks < nks; ++ks) {
        const bf16x8 wb = *(const LAS bf16x8*)(WL + (t0 + r16) * SG_LD + 32 * ks + 8 * g);
#pragma unroll
        for (int ct = 0; ct < 8; ++ct) { const bf16x8 va = *(const LAS bf16x8*)(VNT + (16 * ct + r16) * SG_LD + (((4 * ks + g) ^ (2 * ct + (r16 >> 3))) << 3));
            acc[ct] = __builtin_amdgcn_mfma_f32_16x16x32_bf16(va, wb, acc[ct], 0, 0, 0); }
    }
    const int t = t0 + r16; const float bias = p.sgu_b[(l * 8 + grp) * 128 + t]; const size_t row = row0 + t;
#pragma unroll
    for (int ct = 0; ct < 8; ++ct) { const int ch = grp * 128 + 16 * ct + 4 * g; const u32x2 uw = upre[ct];
        u32x2 o; o.x = pk(bf_lo(uw.x) * (acc[ct][0] + bias), bf_hi(uw.x) * (acc[ct][1] + bias)); o.y = pk(bf_lo(uw.y) * (acc[ct][2] + bias), bf_hi(uw.y) * (acc[ct][3] + bias));
        *(u32x2*)(MO + row * (2 * AW) + ch) = o; }
}
__device__ __forceinline__ void sgu_sample_unit(const Params& p, int l, int s, int tid) {
    asm volatile("" : "+v"(tid));
    const bf16* VS = (const bf16*)(p.ws + WS_VS); const bf16* U = (const bf16*)(p.ws + WS_U); bf16* MO = (bf16*)(p.ws + WS_AO) + AW;
    const u64* vst = (const u64*)(p.ws + WS_STAT) + 8 * MTOK + (size_t)l * 2 * MTOK;
    const size_t row0 = (size_t)NPT + s * 8; const int ch = 2 * tid, grp = ch >> 7;
    const float g0 = p.ln_g[l * 1024 + ch], g1 = p.ln_g[l * 1024 + ch + 1], b0 = p.ln_b[l * 1024 + ch], b1 = p.ln_b[l * 1024 + ch + 1];
    float vn0[8], vn1[8];
#pragma unroll
    for (int t = 0; t < 8; ++t) { const size_t row = row0 + t; const unsigned w = *(const unsigned*)(VS + row * 1024 + ch);
        const float s1 = fx2f(vst[2 * row]), s2 = fx2f(vst[2 * row + 1]), mean = s1 * (1.0f / 1024.0f), var = s2 * (1.0f / 1024.0f) - mean * mean, rstd = rsqrtf(var + LN_EPS);
        vn0[t] = (bf_lo(w) - mean) * rstd * g0 + b0; vn1[t] = (bf_hi(w) - mean) * rstd * g1 + b1;
        *(f32x2*)(p.out + O_SGUV + (((size_t)l * 32 + s) * 8 + t) * 1024 + ch) = (f32x2){vn0[t], vn1[t]}; }
    const float* wg = p.sgu_w + ((size_t)l * 8 + grp) * 128 * 128; const float* bg = p.sgu_b + (l * 8 + grp) * 128;
#pragma unroll
    for (int t = 0; t < 8; ++t) { float m0 = bg[t], m1 = m0;
#pragma unroll
        for (int sp = 0; sp <= t; ++sp) { const float w = wg[t * 128 + sp]; m0 += w * vn0[sp]; m1 += w * vn1[sp]; }
        const size_t row = row0 + t; const unsigned uw = *(const unsigned*)(U + row * 1024 + ch);
        *(unsigned*)(MO + row * (2 * AW) + ch) = pk(bf_lo(uw) * m0, bf_hi(uw) * m1); }
}
__device__ __forceinline__ void phase2(const Params& p, int l, LAS unsigned char* lds, int G, int bid, int tid, int wave, int lane) {
    for (int it = bid; it < 256; it += G) { __syncthreads(); attn_prompt_unit(p, l, it, lds, tid, wave, lane); }
    for (int it = bid, k = 0; it < 512; it += G, ++k) { __syncthreads(); sgu_prompt_unit(p, l, it, lds, tid, wave, lane, k == 0 || (G & 7) != 0); }
    for (int it = bid; it < 128; it += G) { __syncthreads(); attn_sample_unit(p, l, it, lds, tid, wave, lane); }
    for (int it = (bid + G - 128 % G) % G; it < 32; it += G) sgu_sample_unit(p, l, it, tid);
    __syncthreads();
}

#define XB_TMO      128
#define XB_XCNT(j)  (256  + 64 * (j))
#define XB_XSUB(j)  (1280 + 64 * (j))
#define XB_XGEN(j)  (2304 + 64 * (j))
#define XB_TOP      3328
#define XB_TOPGEN   3392
#define XCD_BAR_WORDS 3456
#define XB_SPIN_CAP (1u << 18)

__device__ __forceinline__ unsigned xb_ld(unsigned* p)              { return __hip_atomic_load(p, __ATOMIC_RELAXED, __HIP_MEMORY_SCOPE_AGENT); }
__device__ __forceinline__ unsigned xb_add(unsigned* p, unsigned v) { return __hip_atomic_fetch_add(p, v, __ATOMIC_RELAXED, __HIP_MEMORY_SCOPE_AGENT); }
__device__ __forceinline__ unsigned xb_xcc_id() { return (unsigned)__builtin_amdgcn_s_getreg((3 << 11) | 20) & 0xFu; }
#define XB_SPIN(cond, bar) do { unsigned _sp = 0; while (cond) { __builtin_amdgcn_s_sleep(1); \
    if ((++_sp & 255u) == 0u) { if (xb_ld(&(bar)[XB_TMO])) break; if (_sp > XB_SPIN_CAP) { atomicAdd(&(bar)[XB_TMO], 1u); break; } } } } while (0)

struct XcdBarrier {
    unsigned* bar; unsigned x;
    volatile LAS unsigned* st;
};

__device__ __forceinline__ XcdBarrier xcd_barrier_post(unsigned* bar, volatile LAS unsigned* st) {
    XcdBarrier b; b.bar = bar; b.x = xb_xcc_id(); b.st = st;
    if (threadIdx.x == 0) (void)xb_add(&bar[XB_XCNT(b.x)], 1u);
    return b;
}
__device__ __forceinline__ void xcd_barrier_complete(unsigned* bar, unsigned x, unsigned& nloc, unsigned& nx) {
    const unsigned G = gridDim.x * gridDim.y * gridDim.z;
    unsigned sum, cnt, mine, sp = 0u;
    for (;;) {
        sum = 0u; cnt = 0u; mine = 0u;
#pragma unroll
        for (unsigned j = 0; j < 16; ++j) { const unsigned c = xb_ld(&bar[XB_XCNT(j)]); sum += c; cnt += (c > 0u) ? 1u : 0u; mine = (j == x) ? c : mine; }
        if (sum == G) break;
        __builtin_amdgcn_s_sleep(1);
        if ((++sp & 255u) == 0u) { if (xb_ld(&bar[XB_TMO])) break; if (sp > XB_SPIN_CAP) { atomicAdd(&bar[XB_TMO], 1u); break; } }
    }
    nloc = mine > 0u ? mine : 1u; nx = cnt > 0u ? cnt : 1u;
}

__device__ __forceinline__ void xcd_barrier(const XcdBarrier& b) {
    asm volatile("s_waitcnt vmcnt(0)" ::: "memory");
    __syncthreads();
    if (tid_now() == 0) {
        unsigned* bar = b.bar; asm volatile("" : "+s"(bar)); unsigned bx = b.x; asm volatile("" : "+s"(bx));
        __builtin_amdgcn_s_waitcnt(0);
        unsigned nloc = b.st[0], nx = b.st[1];
        if (nloc == 0u) { xcd_barrier_complete(bar, bx, nloc, nx); b.st[0] = nloc; b.st[1] = nx; }
        const unsigned old = xb_add(&bar[XB_XSUB(bx)], 1u);
        const unsigned gen = old / nloc;
        if (old + 1u == (gen + 1u) * nloc) {
            __builtin_amdgcn_fence(__ATOMIC_RELEASE, "agent");
            asm volatile("s_waitcnt vmcnt(0)" ::: "memory");
            const unsigned og = xb_add(&bar[XB_TOP], 1u);
            const unsigned tg = og / nx;
            if (og + 1u == (tg + 1u) * nx) xb_add(&bar[XB_TOPGEN], 1u);
            else XB_SPIN(xb_ld(&bar[XB_TOPGEN]) == tg, bar);
            __builtin_amdgcn_fence(__ATOMIC_ACQUIRE, "agent");
            xb_add(&bar[XB_XGEN(bx)], 1u);
            asm volatile("s_waitcnt vmcnt(0)" ::: "memory");
        } else {
            XB_SPIN(xb_ld(&bar[XB_XGEN(bx)]) == gen, bar);
            __builtin_amdgcn_fence(__ATOMIC_ACQUIRE, "agent");
            asm volatile("s_waitcnt vmcnt(0)" ::: "memory");
        }
    }
    __syncthreads();
}

__device__ __forceinline__ unsigned char* launder_ws(unsigned char* w) { asm volatile("" : "+s"(w)); return w; }
__global__ void __launch_bounds__(512, 2) fwd_kernel(Params p) {
    extern __shared__ __attribute__((aligned(16))) unsigned char lds_raw[];
    LAS unsigned char* lds = (LAS unsigned char*)lds_raw;
    cg::grid_group grid = cg::this_grid();
    const int tid = threadIdx.x, lane = tid & 63, wave = __builtin_amdgcn_readfirstlane(tid >> 6);
    const int G = gridDim.x, bid = blockIdx.x;
#define WSP(T, off) ((T*)(launder_ws(p.ws) + (off)))
    volatile LAS unsigned* bst = (volatile LAS unsigned*)(lds + 147392);
    if (tid < 2) bst[tid] = 0u;
    __syncthreads();
    const XcdBarrier bar = xcd_barrier_post(WSP(unsigned, WS_BAR), bst);
#define GRID_BAR() xcd_barrier(bar)
    if (p.out == nullptr) grid.sync();
    phase0(p, lds, G, bid, tid, wave, lane);
    GRID_BAR();
    const int gw = bid * 8 + wave, NGW = G * 8;
    for (int l = 0; l < NLAYER; ++l) {
        unsigned* ctr = WSP(unsigned, WS_CNT) + l * 8;
        {
            if (l > 0) { fixup_res<16>(WSP(float, WS_PART), WSP(const bf16, WS_XB), nullptr, WSP(bf16, WS_XB), WSP(u64, WS_STAT) + (size_t)l * MTOK, gw, NGW, lane); split_arrive(ctr + 0); }
            u64* st = WSP(u64, WS_STAT);
            EpiIn E{st + (size_t)l * MTOK, WSP(bf16, WS_QKV), WSP(bf16, WS_U), WSP(bf16, WS_VS), WSP(bf16, WS_GA), WSP(bf16, WS_GM), st + 8 * MTOK + (size_t)l * 2 * MTOK};
            const bf16* win = WSP(const bf16, WS_WIN) + (size_t)l * INC * DM; const bf16* XB = WSP(const bf16, WS_XB);
            { pg8::Gemm g{XB, win, NPT, INC, DM, DM}; pg8::StaticOrder S; S.init(NPT, INC, G, bid); pg8::gemm_phase<EpiIn, pg8::StaticOrder, true, true>(lds, g, S, E); }
            if (l > 0) split_wait(ctr + 0, (unsigned)G);
            { pg8::Gemm g{XB, win, MTOK, INC, DM, DM}; const int nfull = (32 * 30) % G; MiniOrder M{(nfull + 30 <= G) ? nfull : 0, 30, 1, 0, bid}; pg8::gemm_phase<EpiIn, MiniOrder, true, true>(lds, g, M, E); }
        }
        GRID_BAR();
        phase2(p, l, lds, G, bid, tid, wave, lane);
#ifdef PROBE_P2
        phase2(p, l, lds, G, bid, tid, wave, lane);
#endif
        GRID_BAR();
        {
            const bf16* AOM = WSP(const bf16, WS_AO); const bf16* wcat = WSP(const bf16, WS_WAU) + (size_t)l * DM * 2 * AW; float* PART = WSP(float, WS_PART);
            { pg8::Gemm g{AOM, wcat, NPT, DM, 2 * AW, 2 * AW}; pg8::StaticOrder S; S.init(NPT, DM, G, bid); EpiGate E{WSP(const bf16, WS_GA), WSP(const bf16, WS_GM), WSP(bf16, WS_MG)}; pg8::gemm_phase<EpiGate, pg8::StaticOrder, true, true>(lds, g, S, E); }
            { pg8::Gemm g{AOM, wcat, MTOK, DM, 256, 2 * AW}; MiniOrder M{0, 8, 8, 256, bid}; EpiPart E{PART, 8, 0}; pg8::gemm_phase<EpiPart, MiniOrder, true, true>(lds, g, M, E); }
        }
        GRID_BAR();
        {
            const bf16* wo = WSP(const bf16, WS_WOUT) + (size_t)l * DM * DM; bf16* MG = WSP(bf16, WS_MG); bf16* XB = WSP(bf16, WS_XB); u64* ssq2 = WSP(u64, WS_STAT) + (size_t)(4 + l) * MTOK;
            float* PART = WSP(float, WS_PART);
            fixup_merge<4>(PART, WSP(const bf16, WS_GA), WSP(const bf16, WS_GM), MG, gw, NGW, lane); split_arrive(ctr + 1);
            { pg8::Gemm g{MG, wo, NPT, DM, DM, DM}; pg8::StaticOrder S; S.init(NPT, DM, G, bid); EpiRes E{XB, nullptr, XB, ssq2}; pg8::gemm_phase<EpiRes, pg8::StaticOrder, true, true>(lds, g, S, E); }
            split_wait(ctr + 1, (unsigned)G);
            { pg8::Gemm g{MG, wo, MTOK, DM, 256, DM}; MiniOrder M{0, 8, 8, 256, bid}; EpiPart E{PART, 8, 0}; pg8::gemm_phase<EpiPart, MiniOrder, true, true>(lds, g, M, E); }
        }
        GRID_BAR();
        {
            const bf16* w1 = WSP(const bf16, WS_W1) + (size_t)l * FFD * DM; bf16* XB = WSP(bf16, WS_XB); bf16* F = WSP(bf16, WS_F); u64* ssq2 = WSP(u64, WS_STAT) + (size_t)(4 + l) * MTOK;
            float* PART = WSP(float, WS_PART);
            fixup_res<8>(PART, XB, nullptr, XB, ssq2, gw, NGW, lane); split_arrive(ctr + 2);
            { pg8::Gemm g{XB, w1, NPT, FFD, DM, DM}; pg8::StaticOrder S; S.init(NPT, FFD, G, bid); EpiFF1 E{ssq2, F}; pg8::gemm_phase<EpiFF1, pg8::StaticOrder, true, true>(lds, g, S, E); }
#ifdef PROBE_P5
            { pg8::Gemm g{XB, w1, NPT, FFD, DM, DM}; pg8::StaticOrder S; S.init(NPT, FFD, G, bid); EpiFF1 E{ssq2, F}; pg8::gemm_phase<EpiFF1, pg8::StaticOrder, true, true>(lds, g, S, E); }
#endif
            split_wait(ctr + 2, (unsigned)G);
            { pg8::Gemm g{XB, w1, MTOK, FFD, 256, DM}; MiniOrder M{0, 32, 8, 256, bid}; EpiPart E{PART, 8, 0}; pg8::gemm_phase<EpiPart, MiniOrder, true, true>(lds, g, M, E); }
        }
        GRID_BAR();
        {
            const bf16* w2 = WSP(const bf16, WS_W2) + (size_t)l * DM * FFD; bf16* XB = WSP(bf16, WS_XB); bf16* F = WSP(bf16, WS_F); u64* ssq1n = (l + 1 < NLAYER) ? WSP(u64, WS_STAT) + (size_t)(l + 1) * MTOK : nullptr;
            float* PART = WSP(float, WS_PART);
            fixup_ff1<8>(PART, WSP(const u64, WS_STAT) + (size_t)(4 + l) * MTOK, F, gw, NGW, lane); split_arrive(ctr + 3);
            { pg8::Gemm g{F, w2, NPT, DM, FFD, FFD}; pg8::StaticOrder S; S.init(NPT, DM, G, bid); EpiRes E{XB, (l + 1 < NLAYER) ? nullptr : p.out, (l + 1 < NLAYER) ? XB : nullptr, ssq1n};     pg8::gemm_phase<EpiRes, pg8::StaticOrder, true, true>(lds, g, S, E); }
            split_wait(ctr + 3, (unsigned)G);
            { pg8::Gemm g{F, w2, MTOK, DM, 512, FFD}; MiniOrder M{0, 8, 16, 512, bid}; EpiPart E{PART, 16, 0}; pg8::gemm_phase<EpiPart, MiniOrder, true, true>(lds, g, M, E); }
        }
        GRID_BAR();
    }
    fixup_res<16>(WSP(float, WS_PART), WSP(const bf16, WS_XB), p.out, nullptr, nullptr, gw, NGW, lane);
}

extern "C" void kernel_launch(void* const* d_in, const int* in_sizes, int n_in, void* d_out, int out_size, void* d_ws, size_t ws_size, hipStream_t stream) {
    static int grid = 0;
    if (grid == 0) {
        if (n_in != 19 || out_size != (int)O_END || ws_size < WS_END) { fprintf(stderr, "kernel_launch: unexpected shapes (n_in %d, out %d, ws %zu)\n", n_in, out_size, ws_size); grid = -1; return; }
        int dev = 0, cus = 0, per_cu = 0;
        (void)hipGetDevice(&dev); (void)hipDeviceGetAttribute(&cus, hipDeviceAttributeMultiprocessorCount, dev);
        if (hipFuncSetAttribute((const void*)fwd_kernel, hipFuncAttributeMaxDynamicSharedMemorySize, LDS_BYTES) != hipSuccess) { fprintf(stderr, "kernel_launch: hipFuncSetAttribute failed\n"); grid = -1; return; }
        if (hipOccupancyMaxActiveBlocksPerMultiprocessor(&per_cu, (const void*)fwd_kernel, 512, LDS_BYTES) != hipSuccess || per_cu < 1) { fprintf(stderr, "kernel_launch: occupancy query says %d\n", per_cu); per_cu = 1; }
        (void)hipGetLastError();
        grid = cus > 0 ? cus : 256;
    }
    if (grid < 0) return;
    Params p{};
    const float** pp = (const float**)&p;
    for (int i = 0; i < 19; ++i) pp[i] = (const float*)d_in[i];
    p.out = (float*)d_out; p.ws = (unsigned char*)d_ws;
    (void)hipMemsetAsync((unsigned char*)d_ws + WS_CNT, 0, 131072, stream);
    void* args[] = {&p};
    hipError_t e = hipLaunchCooperativeKernel((const void*)fwd_kernel, dim3(grid), dim3(512), args, LDS_BYTES, stream);
    if (e != hipSuccess) fprintf(stderr, "kernel_launch: cooperative launch failed: %s (grid %d)\n", hipGetErrorString(e), grid);
}
```

```cpp
#include <hip/hip_runtime.h>
#include <hip/hip_cooperative_groups.h>
#include <cstdio>
#include <cstdint>
namespace cg = cooperative_groups;
namespace pg8 {
#define PG8_LAS __attribute__((address_space(3)))
typedef unsigned short bf16_t;
typedef short bf16x8 __attribute__((ext_vector_type(8)));
typedef float f32x4 __attribute__((ext_vector_type(4)));
typedef unsigned u32x4 __attribute__((ext_vector_type(4)));
constexpr int BM = 256, BK = 64, HALF = 128, HTB = HALF * BK * 2  , STAGE_BYTES = 8 * HTB, NXCD = 8, WGM = 8;

__host__ __device__ __forceinline__ int lds_byte(int r, int c) { const int st = (r >> 4) * 2 + (c >> 5), rr = r & 15, cc = c & 31, ob = rr * 64 + cc * 2; return st * 1024 + (ob ^ (((ob >> 9) & 1) << 5)); }
__host__ __device__ __forceinline__ void stage_rc(int b, int& R, int& C) { const int st = b / 1024, sb = b % 1024, swz = sb ^ (((sb >> 9) & 1) << 5); R = (st >> 1) * 16 + swz / 64; C = (st & 1) * 32 + (swz % 64) / 2; }
__host__ __device__ __forceinline__ int perm32(int rho) { const int n = rho >> 4, i = rho & 15; return 8 * (i >> 2) + 4 * n + (i & 3); }

struct Unit { int pm, pn, k0, ks; };
struct Gemm { const bf16_t* A; const bf16_t* Bt; int M, N, K, ld; };

struct StaticOrder {
    int nM, nN, nwg, G, c;
    __host__ __device__ void init(int M, int N, int G_, int c_) { nM = M / BM; nN = N / BM; nwg = nM * nN; G = G_; c = c_; }
    __host__ __device__ bool next(int i, Unit& u) const {
        const long L = (long)i * G + c; if (L >= nwg) return false;
        int wgid = (int)L; { const int q = nwg / NXCD, r = nwg % NXCD, xcd = wgid % NXCD, off = wgid / NXCD; wgid = (xcd < r ? xcd * (q + 1) : r * (q + 1) + (xcd - r) * q) + off; }
        const int nig = WGM * nN, gid = wgid / nig, fm = gid * WGM, gsz = (nM - fm) < WGM ? (nM - fm) : WGM;
        u.pm = fm + ((wgid % nig) % gsz); u.pn = (wgid % nig) / gsz; u.k0 = 0; u.ks = 0; return true;
    }
    __device__ __forceinline__ void a_ready(const Unit&) const {}
    __device__ __forceinline__ void done(const Unit&) const {}
};

__device__ __forceinline__ unsigned cvt_pk_bf16(float lo, float hi) { unsigned r; asm volatile("v_cvt_pk_bf16_f32 %0, %1, %2" : "=v"(r) : "v"(lo), "v"(hi)); return r; }
typedef float f32x2 __attribute__((ext_vector_type(2)));
__device__ __forceinline__ f32x2 gelu_pk(f32x2 v) {
    const f32x2 av = __builtin_elementwise_abs(v), d = av * 0.2316418882f + 1.0f;
    f32x2 t; t.x = __builtin_amdgcn_rcpf(d.x); t.y = __builtin_amdgcn_rcpf(d.y);
    f32x2 q = t * 0.5307027145f + (-0.7265760135f); q = q * t + 0.7107068705f; q = q * t + (-0.142248368f); q = q * t + 0.127414796f; q = q * t;
    const f32x2 s = (v * v) * (-0.72134752044f);
    f32x2 e; e.x = __builtin_amdgcn_exp2f(s.x); e.y = __builtin_amdgcn_exp2f(s.y);
    const f32x2 m = v * (q * e), r = v - m;
    f32x2 o; o.x = v.x < 0.f ? m.x : r.x; o.y = v.y < 0.f ? m.y : r.y; return o;
}

template <int ACT  > struct EpiBf16 {
    static constexpr bool PERM = true, AFTER_DRAIN = false, HAS_MID = false, HAS_INIT = false; static_assert(ACT == 0 || ACT == 1, "EpiBf16: ACT is 0 (none) or 1 (gelu_pk)");
    bf16_t* O; int ldc; const float* bias; int split_cols; size_t split_stride; float scale0;
    __device__ __forceinline__ void operator()(const f32x4 (&acc)[2][2][4][2], const Unit& u, int wr, int wc, int fr, int fq) const {
        const int row0 = u.pm * BM + wr * 64 + fr; int colt = u.pn * BM; bf16_t* base = O;
        float sc = 1.f; if (split_cols) { const int t = colt / split_cols; base += (size_t)t * split_stride; colt -= t * split_cols; if (t == 0) sc = scale0; }
        const int col0 = colt + wc * 32 + 8 * fq, bcol0 = u.pn * BM + wc * 32 + 8 * fq;
        f32x4 bv[2][2];
#pragma unroll
        for (int bj = 0; bj < 2; ++bj)
#pragma unroll
            for (int n = 0; n < 2; ++n) bv[bj][n] = bias ? *(const f32x4*)(bias + bcol0 + bj * HALF + 4 * n) : (f32x4){0.f, 0.f, 0.f, 0.f};
#pragma unroll
        for (int ai = 0; ai < 2; ++ai)
#pragma unroll
            for (int m = 0; m < 4; ++m) { bf16_t* rowp = base + (size_t)(row0 + ai * HALF + m * 16) * ldc + col0;
#pragma unroll
                for (int bj = 0; bj < 2; ++bj) { f32x4 v0 = acc[ai][bj][m][0] + bv[bj][0], v1 = acc[ai][bj][m][1] + bv[bj][1];
                    if (ACT == 1) { f32x2 a = gelu_pk((f32x2){v0[0], v0[1]}), b = gelu_pk((f32x2){v0[2], v0[3]}), c = gelu_pk((f32x2){v1[0], v1[1]}), d = gelu_pk((f32x2){v1[2], v1[3]});
                        v0 = (f32x4){a.x, a.y, b.x, b.y}; v1 = (f32x4){c.x, c.y, d.x, d.y}; }
                    v0 = v0 * sc; v1 = v1 * sc; u32x4 w; w.x = cvt_pk_bf16(v0[0], v0[1]); w.y = cvt_pk_bf16(v0[2], v0[3]); w.z = cvt_pk_bf16(v1[0], v1[1]); w.w = cvt_pk_bf16(v1[2], v1[3]);
                    *(u32x4*)(rowp + bj * HALF) = w; } }
    }
};

template <class Epi, class Sched, bool ALIGN_EPI = false, bool SP2 = false>
__device__ __forceinline__ void gemm_phase(PG8_LAS unsigned char* lds, const Gemm g, const Sched& S, const Epi& E) {
    int tid_raw = threadIdx.x; asm volatile("" : "+v"(tid_raw));
    const int tid = tid_raw, wid = __builtin_amdgcn_readfirstlane(tid >> 6), lane = tid & 63, wr = wid >> 2, wc = wid & 3, fr = lane & 15, fq = lane >> 4;
    const int K = g.ld, nt = g.K / BK;
    unsigned voffA[2], voffB[2];
#pragma unroll
    for (int i = 0; i < 2; ++i) { int R, C; stage_rc(tid * 16 + i * 8192, R, C); const int Rb = Epi::PERM ? ((R & ~31) + perm32(R & 31)) : R;
        voffA[i] = (unsigned)(R * K + C) * 2u; voffB[i] = (unsigned)(Rb * K + C) * 2u; }
    const size_t kstep = (size_t)(BK * 2);
    const size_t hstep = (size_t)HALF * K * 2;
    const size_t tstep = 2 * hstep;
    const unsigned ldsw = (unsigned)wid * 1024u;
    const int aoff = lds_byte(wr * 64 + fr, fq * 8), boff = lds_byte(wc * 32 + fr, fq * 8);
#define PG8_SA(b, h) (((b) * 2 + (h)) * HTB)
#define PG8_SB(b, h) ((4 + (b) * 2 + (h)) * HTB)
#define PG8_STAGE(bufoff, gbase, voff) do { _Pragma("unroll") for (int _i = 0; _i < 2; ++_i) \
        __builtin_amdgcn_global_load_lds((const unsigned*)((const char*)(gbase) + (voff)[_i]), (PG8_LAS unsigned*)(lds + (bufoff) + ldsw + _i * 8192), 16, 0, 0); } while (0)
#define PG8_LDA(dst, b, h) do { _Pragma("unroll") for (int m = 0; m < 4; ++m) _Pragma("unroll") for (int k = 0; k < 2; ++k) dst[m][k] = *(const PG8_LAS bf16x8*)(lds + PG8_SA(b, h) + aoff + m * 2048 + k * 1024); } while (0)
#define PG8_LDB(dst, b, h) do { _Pragma("unroll") for (int n = 0; n < 2; ++n) _Pragma("unroll") for (int k = 0; k < 2; ++k) dst[n][k] = *(const PG8_LAS bf16x8*)(lds + PG8_SB(b, h) + boff + n * 2048 + k * 1024); } while (0)
#define PG8_MMA(ai, bj, At, Bt) do { __builtin_amdgcn_s_setprio(1); _Pragma("unroll") for (int m = 0; m < 4; ++m) _Pragma("unroll") for (int n = 0; n < 2; ++n) _Pragma("unroll") for (int k = 0; k < 2; ++k) \
        acc[ai][bj][m][n] = __builtin_amdgcn_mfma_f32_16x16x32_bf16(Bt[n][k], At[m][k], acc[ai][bj][m][n], 0, 0, 0); __builtin_amdgcn_s_setprio(0); } while (0)
#define PG8_WAIT_V(n) asm volatile("s_waitcnt vmcnt(" #n ")" ::: "memory")
#define PG8_WAIT_L(n) asm volatile("s_waitcnt lgkmcnt(" #n ")" ::: "memory")
#define PG8_BAR __builtin_amdgcn_s_barrier()
#define PG8_SCHED __builtin_amdgcn_sched_barrier(0)
    Unit cur, nxt; int ui = 0;
    if (!S.next(0, cur)) return;
    f32x4 acc[2][2][4][2];
    if constexpr (Epi::HAS_INIT) E.init(acc, cur, wr, wc, fr, fq);
    else {
#pragma unroll
    for (int a = 0; a < 2; ++a)
#pragma unroll
        for (int b = 0; b < 2; ++b)
#pragma unroll
            for (int m = 0; m < 4; ++m)
#pragma unroll
                for (int n = 0; n < 2; ++n) acc[a][b][m][n] = (f32x4){0.f, 0.f, 0.f, 0.f};
    }
    bf16x8 At[4][2], B0[2][2], B1[2][2];
    const char* cA = (const char*)g.A + (size_t)cur.pm * tstep + (size_t)cur.k0 * 2; const char* cB = (const char*)g.Bt + (size_t)cur.pn * tstep + (size_t)cur.k0 * 2;
    S.a_ready(cur);
    if constexpr (SP2) {
        PG8_STAGE(PG8_SB(0, 0), cB, voffB); PG8_STAGE(PG8_SB(0, 1), cB + hstep, voffB); PG8_STAGE(PG8_SA(0, 0), cA, voffA); PG8_STAGE(PG8_SA(0, 1), cA + hstep, voffA);
        if (wr == 1) PG8_BAR;
        PG8_WAIT_V(2); PG8_BAR;
        PG8_STAGE(PG8_SB(1, 0), cB + kstep, voffB); PG8_STAGE(PG8_SA(1, 0), cA + kstep, voffA); PG8_STAGE(PG8_SB(1, 1), cB + hstep + kstep, voffB);
        PG8_WAIT_V(6); PG8_BAR;
    } else {
        PG8_STAGE(PG8_SB(0, 0), cB, voffB); PG8_STAGE(PG8_SA(0, 0), cA, voffA); PG8_STAGE(PG8_SB(0, 1), cB + hstep, voffB); PG8_STAGE(PG8_SA(0, 1), cA + hstep, voffA);
        if (wr == 1) PG8_BAR;
        PG8_WAIT_V(4); PG8_BAR;
        PG8_STAGE(PG8_SB(1, 0), cB + kstep, voffB); PG8_STAGE(PG8_SA(1, 0), cA + kstep, voffA); PG8_STAGE(PG8_SB(1, 1), cB + hstep + kstep, voffB);
        PG8_WAIT_V(6); PG8_BAR;
    }
    if constexpr (Epi::HAS_INIT) {
#pragma unroll
        for (int a = 0; a < 2; ++a)
#pragma unroll
            for (int b = 0; b < 2; ++b)
#pragma unroll
                for (int m = 0; m < 4; ++m) asm volatile("" : "+v"(acc[a][b][m][0]), "+v"(acc[a][b][m][1]));
    }
    for (;;) {
        const bool has_next = S.next(ui + 1, nxt);
        const char* nA = has_next ? (const char*)g.A + (size_t)nxt.pm * tstep + (size_t)nxt.k0 * 2 : cA; const char* nB = has_next ? (const char*)g.Bt + (size_t)nxt.pn * tstep + (size_t)nxt.k0 * 2 : cB;
        for (int t = 0; t < nt; t += 2) {
            if constexpr (Epi::HAS_MID) { if (t == nt / 2) E.mid(acc, cur, wr, wc, fr, fq); }
            const bool last = (t == nt - 2);
            const char* a1 = cA + (size_t)(t + 1) * kstep;
            const char* a2 = last ? nA : cA + (size_t)(t + 2) * kstep; const char* b2 = last ? nB : cB + (size_t)(t + 2) * kstep;
            const char* a3 = a2 + kstep; const char* b3 = b2 + kstep;
            if (last && has_next) S.a_ready(nxt);
            if constexpr (SP2) {
            PG8_LDB(B0, 0, 0); PG8_LDB(B1, 0, 1); PG8_SCHED; PG8_LDA(At, 0, 0); PG8_STAGE(PG8_SA(1, 1), a1 + hstep, voffA);
            PG8_WAIT_V(8); PG8_WAIT_L(0); PG8_BAR; PG8_MMA(0, 0, At, B0); PG8_MMA(0, 1, At, B1); PG8_BAR; PG8_SCHED;
            PG8_LDA(At, 0, 1); PG8_STAGE(PG8_SB(0, 0), b2, voffB); PG8_STAGE(PG8_SB(0, 1), b2 + hstep, voffB); PG8_STAGE(PG8_SA(0, 0), a2, voffA);
            PG8_WAIT_V(8); PG8_WAIT_L(0); PG8_BAR; PG8_MMA(1, 0, At, B0); PG8_MMA(1, 1, At, B1); PG8_BAR; PG8_SCHED;
            PG8_LDB(B0, 1, 0); PG8_LDB(B1, 1, 1); PG8_SCHED; PG8_LDA(At, 1, 0); PG8_STAGE(PG8_SA(0, 1), a2 + hstep, voffA);
            PG8_WAIT_V(8); PG8_WAIT_L(0); PG8_BAR; PG8_MMA(0, 0, At, B0); PG8_MMA(0, 1, At, B1); PG8_BAR; PG8_SCHED;
            PG8_LDA(At, 1, 1); PG8_STAGE(PG8_SB(1, 0), b3, voffB); PG8_STAGE(PG8_SB(1, 1), b3 + hstep, voffB); PG8_STAGE(PG8_SA(1, 0), a3, voffA);
            PG8_WAIT_V(8); PG8_WAIT_L(0); PG8_BAR; PG8_MMA(1, 0, At, B0); PG8_MMA(1, 1, At, B1); PG8_BAR; PG8_SCHED;
            } else {
            PG8_LDB(B0, 0, 0); PG8_SCHED; PG8_LDA(At, 0, 0); PG8_STAGE(PG8_SA(1, 1), a1 + hstep, voffA);
            PG8_WAIT_L(8); PG8_BAR; PG8_WAIT_L(0); PG8_MMA(0, 0, At, B0); PG8_BAR; PG8_SCHED;
            PG8_LDB(B1, 0, 1); PG8_STAGE(PG8_SB(0, 0), b2, voffB);
            PG8_BAR; PG8_WAIT_L(0); PG8_MMA(0, 1, At, B1); PG8_BAR;
            PG8_LDA(At, 0, 1); PG8_STAGE(PG8_SA(0, 0), a2, voffA);
            PG8_BAR; PG8_WAIT_L(0); PG8_MMA(1, 0, At, B0); PG8_BAR; PG8_SCHED;
            PG8_STAGE(PG8_SB(0, 1), b2 + hstep, voffB);
            PG8_WAIT_V(6); PG8_BAR; PG8_MMA(1, 1, At, B1); PG8_BAR;
            PG8_LDB(B0, 1, 0); PG8_SCHED; PG8_LDA(At, 1, 0); PG8_STAGE(PG8_SA(0, 1), a2 + hstep, voffA);
            PG8_WAIT_L(8); PG8_BAR; PG8_WAIT_L(0); PG8_MMA(0, 0, At, B0); PG8_BAR; PG8_SCHED;
            PG8_LDB(B1, 1, 1); PG8_STAGE(PG8_SB(1, 0), b3, voffB);
            PG8_BAR; PG8_WAIT_L(0); PG8_MMA(0, 1, At, B1); PG8_BAR;
            PG8_LDA(At, 1, 1); PG8_STAGE(PG8_SA(1, 0), a3, voffA);
            PG8_BAR; PG8_WAIT_L(0); PG8_MMA(1, 0, At, B0); PG8_BAR; PG8_SCHED;
            PG8_STAGE(PG8_SB(1, 1), b3 + hstep, voffB);
            PG8_WAIT_V(6); PG8_BAR; PG8_MMA(1, 1, At, B1); PG8_BAR;
            }
        }
        if constexpr (ALIGN_EPI) { if (wr == 0) PG8_BAR; }
        if constexpr (!Epi::AFTER_DRAIN) { E(acc, cur, wr, wc, fr, fq); S.done(cur); }
        if (!has_next) break;
        if constexpr (Epi::HAS_INIT) { E.init(acc, nxt, wr, wc, fr, fq);
#pragma unroll
            for (int a = 0; a < 2; ++a)
#pragma unroll
                for (int b = 0; b < 2; ++b)
#pragma unroll
                    for (int m = 0; m < 4; ++m) asm volatile("" : "+v"(acc[a][b][m][0]), "+v"(acc[a][b][m][1]));
        } else {
#pragma unroll
        for (int a = 0; a < 2; ++a)
#pragma unroll
            for (int b = 0; b < 2; ++b)
#pragma unroll
                for (int m = 0; m < 4; ++m)
#pragma unroll
                    for (int n = 0; n < 2; ++n) acc[a][b][m][n] = (f32x4){0.f, 0.f, 0.f, 0.f};
        }
        cur = nxt; cA = nA; cB = nB; ++ui;
        if constexpr (ALIGN_EPI) { if (wr == 1) PG8_BAR; }
    }
    PG8_WAIT_V(0);
    if constexpr (!ALIGN_EPI) { if (wr == 0) PG8_BAR; }
    PG8_BAR;
    if constexpr (Epi::AFTER_DRAIN) { E.fused(acc, cur, wr, wc, fr, fq, lds, wid, lane); S.done(cur); }
#undef PG8_SA
#undef PG8_SB
#undef PG8_STAGE
#undef PG8_LDA
#undef PG8_LDB
#undef PG8_MMA
#undef PG8_WAIT_V
#undef PG8_WAIT_L
#undef PG8_BAR
#undef PG8_SCHED
}
}

#define LAS __attribute__((address_space(3)))
typedef unsigned short bf16;
typedef float f32x4 __attribute__((ext_vector_type(4)));
typedef float f32x2 __attribute__((ext_vector_type(2)));
typedef unsigned u32x4 __attribute__((ext_vector_type(4)));
typedef unsigned u32x2 __attribute__((ext_vector_type(2)));
typedef short bf16x8 __attribute__((ext_vector_type(8)));
typedef short s16x4 __attribute__((ext_vector_type(4)));

constexpr int DM = 2048, SEQ = 4096, NPT = 8192, MTOK = 8448, NLAYER = 4;
constexpr int INC = 7680, FFD = 8192, AW = 1024, QKVW = 1536;
constexpr size_t MiB = 1u << 20;
constexpr size_t WS_WIN = 0, WS_WAU = 120 * MiB, WS_WSU = 136 * MiB, WS_WOUT = 152 * MiB, WS_W1 = 184 * MiB, WS_W2 = 312 * MiB;
constexpr size_t WS_XB = 440 * MiB, WS_QKV = 473 * MiB, WS_U = 498 * MiB, WS_VS = 515 * MiB, WS_GA = 532 * MiB, WS_GM = 565 * MiB;
constexpr size_t WS_AO = 598 * MiB, WS_MO = 615 * MiB, WS_MG = 632 * MiB, WS_F = 665 * MiB, WS_STAT = 797 * MiB, WS_CNT = 799 * MiB, WS_BAR = 799 * MiB + 65536, WS_PART = 800 * MiB, WS_END = 864 * MiB;
constexpr size_t WS_TMP = WS_F;
constexpr size_t O_KP = 17301504, O_VP = 17563648, O_KS = 17825792, O_VSAMP = 22020096, O_SGUV = 26214400, O_END = 27262976;
constexpr int LDS_BYTES = 147456;
constexpr float RMS_EPS = 1e-6f, LN_EPS = 1e-5f;

struct Params {
    const float *x_prompt, *x_sample, *cache_k, *cache_v, *norm1_g, *w_in, *q_norm_g, *k_norm_g, *sinks, *ln_g, *ln_b, *sgu_w, *sgu_b, *w_au, *w_su, *w_out, *norm2_g, *w_ff1, *w_ff2;
    float* out; unsigned char* ws;
};

__device__ __forceinline__ float bf_lo(unsigned w) { return __uint_as_float(w << 16); }
__device__ __forceinline__ float bf_hi(unsigned w) { return __uint_as_float(w & 0xffff0000u); }
__device__ __forceinline__ unsigned pk(float lo, float hi) { return pg8::cvt_pk_bf16(lo, hi); }
__device__ __forceinline__ void unpack8(u32x4 w, float* f) { f[0] = bf_lo(w.x); f[1] = bf_hi(w.x); f[2] = bf_lo(w.y); f[3] = bf_hi(w.y); f[4] = bf_lo(w.z); f[5] = bf_hi(w.z); f[6] = bf_lo(w.w); f[7] = bf_hi(w.w); }
__device__ __forceinline__ u32x4 pack8(const float* f) { u32x4 w; w.x = pk(f[0], f[1]); w.y = pk(f[2], f[3]); w.z = pk(f[4], f[5]); w.w = pk(f[6], f[7]); return w; }
__device__ __forceinline__ float wave_sum(float v) {
#pragma unroll
    for (int o = 1; o < 64; o <<= 1) v += __shfl_xor(v, o);
    return v;
}
typedef unsigned long long u64;
__device__ __forceinline__ float fx2f(u64 v) { return (float)(long long)v * (1.0f / 1048576.0f); }
__device__ __forceinline__ u64 f2fx(float s) { return (u64)(long long)(s * 1048576.0f); }
__device__ __forceinline__ void unpack8u(u32x2 w, float* f) { f[0] = (float)(w.x & 0xffu); f[1] = (float)((w.x >> 8) & 0xffu); f[2] = (float)((w.x >> 16) & 0xffu); f[3] = (float)(w.x >> 24);
    f[4] = (float)(w.y & 0xffu); f[5] = (float)((w.y >> 8) & 0xffu); f[6] = (float)((w.y >> 16) & 0xffu); f[7] = (float)(w.y >> 24); }
__device__ __forceinline__ float sigmoidf_(float x) { return __builtin_amdgcn_rcpf(1.0f + __expf(-x)); }

struct EpiIn {
    static constexpr bool PERM = true, AFTER_DRAIN = false, HAS_MID = false, HAS_INIT = false;
    const u64* ssq; bf16 *QKV, *U, *VS, *GA, *GM; u64* vstat;
    __device__ __forceinline__ void operator()(const f32x4 (&acc)[2][2][4][2], const pg8::Unit& u, int wr, int wc, int fr, int fq) const {
        const int pn = u.pn, row0 = u.pm * 256 + wr * 64 + fr, cw = wc * 32 + 8 * fq;
        int kind, ld, colt; bf16* base;
        if (pn < 6) { kind = 0; base = QKV; ld = QKVW; colt = pn * 256; }
        else if (pn < 10) { kind = 1; base = U; ld = 1024; colt = (pn - 6) * 256; }
        else if (pn < 14) { kind = 2; base = VS; ld = 1024; colt = (pn - 10) * 256; }
        else if (pn < 22) { kind = 3; base = GA; ld = DM; colt = (pn - 14) * 256; }
        else { kind = 3; base = GM; ld = DM; colt = (pn - 22) * 256; }
#pragma unroll
        for (int ai = 0; ai < 2; ++ai)
#pragma unroll
            for (int m = 0; m < 4; ++m) {
                const int row = row0 + ai * 128 + m * 16;
                const float rs = rsqrtf(fx2f(ssq[row]) * (1.0f / DM) + RMS_EPS);
                float s1 = 0.f, s2 = 0.f;
#pragma unroll
                for (int bj = 0; bj < 2; ++bj) {
                    f32x4 v0 = acc[ai][bj][m][0] * rs, v1 = acc[ai][bj][m][1] * rs;
                    if (kind == 1 || kind == 2) {
                        pg8::f32x2 a = pg8::gelu_pk((pg8::f32x2){v0[0], v0[1]}), b = pg8::gelu_pk((pg8::f32x2){v0[2], v0[3]}), c = pg8::gelu_pk((pg8::f32x2){v1[0], v1[1]}), d = pg8::gelu_pk((pg8::f32x2){v1[2], v1[3]});
                        v0 = (f32x4){a.x, a.y, b.x, b.y}; v1 = (f32x4){c.x, c.y, d.x, d.y};
                        if (kind == 2) { s1 += (v0[0] + v0[1]) + (v0[2] + v0[3]) + (v1[0] + v1[1]) + (v1[2] + v1[3]);
                            s2 += (v0[0] * v0[0] + v0[1] * v0[1]) + (v0[2] * v0[2] + v0[3] * v0[3]) + (v1[0] * v1[0] + v1[1] * v1[1]) + (v1[2] * v1[2] + v1[3] * v1[3]); }
                    } else if (kind == 3) {
                        unsigned q0 = 0u, q1 = 0u;
#pragma unroll
                        for (int k = 0; k < 4; ++k) { q0 = __builtin_amdgcn_cvt_pk_u8_f32(fmaxf(sigmoidf_(v0[k]) * 255.0f, 1.0f), k, q0); q1 = __builtin_amdgcn_cvt_pk_u8_f32(fmaxf(sigmoidf_(v1[k]) * 255.0f, 1.0f), k, q1); }
                        u32x2 qw; qw.x = q0; qw.y = q1;
                        *(u32x2*)((unsigned char*)base + (size_t)row * ld + colt + bj * 128 + cw) = qw;
                        continue;
                    }
                    u32x4 w; w.x = pk(v0[0], v0[1]); w.y = pk(v0[2], v0[3]); w.z = pk(v1[0], v1[1]); w.w = pk(v1[2], v1[3]);
                    *(u32x4*)(base + (size_t)row * ld + colt + bj * 128 + cw) = w;
                }
                if (kind == 2) {
                    s1 += __shfl_xor(s1, 16); s1 += __shfl_xor(s1, 32); s2 += __shfl_xor(s2, 16); s2 += __shfl_xor(s2, 32);
                    if (fq == 0) { atomicAdd(vstat + 2 * (size_t)row, f2fx(s1)); atomicAdd(vstat + 2 * (size_t)row + 1, f2fx(s2)); }
                }
            }
    }
};
struct EpiRes {
    static constexpr bool PERM = true, AFTER_DRAIN = false, HAS_MID = false, HAS_INIT = true;
    const bf16* xsrc; float* out32; bf16* xb; u64* ssq;
    __device__ __forceinline__ void init(f32x4 (&acc)[2][2][4][2], const pg8::Unit& u, int wr, int wc, int fr, int fq) const {
        const int row0 = u.pm * 256 + wr * 64 + fr, col0 = u.pn * 256 + wc * 32 + 8 * fq;
        u32x4 w[2][4][2];
#pragma unroll
        for (int ai = 0; ai < 2; ++ai)
#pragma unroll
            for (int m = 0; m < 4; ++m)
#pragma unroll
                for (int bj = 0; bj < 2; ++bj) w[ai][m][bj] = *(const u32x4*)(xsrc + (size_t)(row0 + ai * 128 + m * 16) * DM + col0 + bj * 128);
#pragma unroll
        for (int ai = 0; ai < 2; ++ai)
#pragma unroll
            for (int m = 0; m < 4; ++m)
#pragma unroll
                for (int bj = 0; bj < 2; ++bj) { const u32x4 q = w[ai][m][bj]; acc[ai][bj][m][0] = (f32x4){bf_lo(q.x), bf_hi(q.x), bf_lo(q.y), bf_hi(q.y)}; acc[ai][bj][m][1] = (f32x4){bf_lo(q.z), bf_hi(q.z), bf_lo(q.w), bf_hi(q.w)}; }
    }
    __device__ __forceinline__ void operator()(const f32x4 (&acc)[2][2][4][2], const pg8::Unit& u, int wr, int wc, int fr, int fq) const {
        const int row0 = u.pm * 256 + wr * 64 + fr, col0 = u.pn * 256 + wc * 32 + 8 * fq;
#pragma unroll
        for (int ai = 0; ai < 2; ++ai)
#pragma unroll
            for (int m = 0; m < 4; ++m) {
                const int row = row0 + ai * 128 + m * 16; float s = 0.f;
#pragma unroll
                for (int bj = 0; bj < 2; ++bj) {
                    const size_t off = (size_t)row * DM + col0 + bj * 128;
                    const f32x4 o0 = acc[ai][bj][m][0], o1 = acc[ai][bj][m][1];
                    if (out32) { *(f32x4*)(out32 + off) = o0; *(f32x4*)(out32 + off + 4) = o1; }
                    if (xb) { u32x4 w; w.x = pk(o0[0], o0[1]); w.y = pk(o0[2], o0[3]); w.z = pk(o1[0], o1[1]); w.w = pk(o1[2], o1[3]); *(u32x4*)(xb + off) = w; }
                    s += (o0[0] * o0[0] + o0[1] * o0[1]) + (o0[2] * o0[2] + o0[3] * o0[3]) + (o1[0] * o1[0] + o1[1] * o1[1]) + (o1[2] * o1[2] + o1[3] * o1[3]);
                }
                s += __shfl_xor(s, 16); s += __shfl_xor(s, 32);
                if (fq == 0 && ssq) atomicAdd(ssq + row, f2fx(s));
            }
    }
};
struct EpiFF1 {
    static constexpr bool PERM = true, AFTER_DRAIN = false, HAS_MID = false, HAS_INIT = false;
    const u64* ssq; bf16* F;
    __device__ __forceinline__ void operator()(const f32x4 (&acc)[2][2][4][2], const pg8::Unit& u, int wr, int wc, int fr, int fq) const {
        const int row0 = u.pm * 256 + wr * 64 + fr, col0 = u.pn * 256 + wc * 32 + 8 * fq;
#pragma unroll
        for (int ai = 0; ai < 2; ++ai)
#pragma unroll
            for (int m = 0; m < 4; ++m) {
                const int row = row0 + ai * 128 + m * 16;
                const float rs = rsqrtf(fx2f(ssq[row]) * (1.0f / DM) + RMS_EPS);
#pragma unroll
                for (int bj = 0; bj < 2; ++bj) {
                    f32x4 v0 = acc[ai][bj][m][0] * rs, v1 = acc[ai][bj][m][1] * rs;
#pragma unroll
                    for (int k = 0; k < 4; ++k) { const float a = fmaxf(v0[k], 0.f), b = fmaxf(v1[k], 0.f); v0[k] = a * a; v1[k] = b * b; }
                    u32x4 w; w.x = pk(v0[0], v0[1]); w.y = pk(v0[2], v0[3]); w.z = pk(v1[0], v1[1]); w.w = pk(v1[2], v1[3]);
                    *(u32x4*)(F + (size_t)row * FFD + col0 + bj * 128) = w;
                }
            }
    }
};
struct EpiGate {
    static constexpr bool PERM = true, AFTER_DRAIN = false, HAS_MID = true, HAS_INIT = false;
    const bf16 *ga, *gm; bf16* mg;
    __device__ __forceinline__ void mid(f32x4 (&acc)[2][2][4][2], const pg8::Unit& u, int wr, int wc, int fr, int fq) const {
        int row0 = u.pm * 256 + wr * 64 + fr, col0 = u.pn * 256 + wc * 32 + 8 * fq;
        asm volatile("" : "+v"(row0), "+v"(col0));
#pragma unroll
        for (int ai = 0; ai < 2; ++ai) {
            u32x2 w1[4][2], w2[4][2];
#pragma unroll
            for (int m = 0; m < 4; ++m)
#pragma unroll
                for (int bj = 0; bj < 2; ++bj) { const size_t off = (size_t)(row0 + ai * 128 + m * 16) * DM + col0 + bj * 128; w1[m][bj] = *(const u32x2*)((const unsigned char*)ga + off); w2[m][bj] = *(const u32x2*)((const unsigned char*)gm + off); }
#pragma unroll
            for (int m = 0; m < 4; ++m)
#pragma unroll
                for (int bj = 0; bj < 2; ++bj) {
                    float g1[8], g2[8]; unpack8u(w1[m][bj], g1); unpack8u(w2[m][bj], g2);
#pragma unroll
                    for (int k = 0; k < 4; ++k) { acc[ai][bj][m][0][k] *= g1[k] * __builtin_amdgcn_rcpf(fmaxf(g2[k], 1e-30f)); acc[ai][bj][m][1][k] *= g1[4 + k] * __builtin_amdgcn_rcpf(fmaxf(g2[4 + k], 1e-30f)); }
                }
            __builtin_amdgcn_sched_barrier(0);
        }
    }
    __device__ __forceinline__ void operator()(const f32x4 (&acc)[2][2][4][2], const pg8::Unit& u, int wr, int wc, int fr, int fq) const {
        const int row0 = u.pm * 256 + wr * 64 + fr, col0 = u.pn * 256 + wc * 32 + 8 * fq;
#pragma unroll
        for (int ai = 0; ai < 2; ++ai)
#pragma unroll
            for (int m = 0; m < 4; ++m) {
                const int row = row0 + ai * 128 + m * 16;
#pragma unroll
                for (int bj = 0; bj < 2; ++bj) {
                    const size_t off = (size_t)row * DM + col0 + bj * 128;
                    float g2[8]; unpack8u(*(const u32x2*)((const unsigned char*)gm + off), g2);
#pragma unroll
                    for (int k = 0; k < 8; ++k) g2[k] *= (1.0f / 255.0f);
                    const f32x4 v0 = acc[ai][bj][m][0], v1 = acc[ai][bj][m][1];
                    u32x4 w; w.x = pk(v0[0] * g2[0], v0[1] * g2[1]); w.y = pk(v0[2] * g2[2], v0[3] * g2[3]); w.z = pk(v1[0] * g2[4], v1[1] * g2[5]); w.w = pk(v1[2] * g2[6], v1[3] * g2[7]);
                    *(u32x4*)(mg + off) = w;
                }
            }
    }
};

struct MiniOrder {
    int c0, ntile, S, kchunk, c;
    __device__ __forceinline__ bool next(int i, pg8::Unit& u) const { const int j = c - c0; if (i != 0 || j < 0 || j >= ntile * S) return false; u.pm = NPT / 256; u.pn = j / S; u.ks = j % S; u.k0 = u.ks * kchunk; return true; }
    __device__ __forceinline__ void a_ready(const pg8::Unit&) const {}
    __device__ __forceinline__ void done(const pg8::Unit&) const {}
};
struct EpiPart {
    static constexpr bool PERM = true, AFTER_DRAIN = false, HAS_MID = false, HAS_INIT = false;
    float* part; int slots, slot0;
    __device__ __forceinline__ void operator()(const f32x4 (&acc)[2][2][4][2], const pg8::Unit& u, int wr, int wc, int fr, int fq) const {
        bf16* pt = (bf16*)part + (size_t)(u.pn * slots + slot0 + u.ks) * 65536;
#pragma unroll
        for (int ai = 0; ai < 2; ++ai)
#pragma unroll
            for (int m = 0; m < 4; ++m)
#pragma unroll
                for (int bj = 0; bj < 2; ++bj) { const f32x4 v0 = acc[ai][bj][m][0], v1 = acc[ai][bj][m][1];
                    u32x4 w; w.x = pk(v0[0], v0[1]); w.y = pk(v0[2], v0[3]); w.z = pk(v1[0], v1[1]); w.w = pk(v1[2], v1[3]);
                    *(u32x4*)(pt + (ai * 128 + wr * 64 + m * 16 + fr) * 256 + bj * 128 + wc * 32 + 8 * fq) = w; }
    }
};
__device__ __forceinline__ f32x4 ld_part4(const bf16* p) { const u32x2 w = *(const u32x2*)p; return (f32x4){bf_lo(w.x), bf_hi(w.x), bf_lo(w.y), bf_hi(w.y)}; }
__device__ __forceinline__ void st_wt8(void* p, unsigned lo, unsigned hi) { __hip_atomic_store((u64*)p, ((u64)hi << 32) | (u64)lo, __ATOMIC_RELAXED, __HIP_MEMORY_SCOPE_AGENT); }
template <int S> __device__ __forceinline__ void fixup_res(const float* part, const bf16* xsrc, float* out32, bf16* xb, u64* ssq, int gw, int NGW, int lane) {
    for (int it = gw; it < 8 * 256; it += NGW) { const int pn = it >> 8, r = it & 255;
        const bf16* pp = (const bf16*)part + (size_t)(pn * S) * 65536 + r * 256 + 4 * lane;
        f32x4 v[S];
#pragma unroll
        for (int sp = 0; sp < S; ++sp) v[sp] = ld_part4(pp + (size_t)sp * 65536);
        f32x4 a = v[0];
#pragma unroll
        for (int sp = 1; sp < S; ++sp) a += v[sp];
        const size_t off = (size_t)(NPT + r) * DM + pn * 256 + 4 * lane;
        const f32x4 o = ld_part4(xsrc + off) + a;
        if (out32) *(f32x4*)(out32 + off) = o;
        if (xb) st_wt8(xb + off, pk(o[0], o[1]), pk(o[2], o[3]));
        const float sq = wave_sum((o[0] * o[0] + o[1] * o[1]) + (o[2] * o[2] + o[3] * o[3]));
        if (lane == 0 && ssq) atomicAdd(ssq + NPT + r, f2fx(sq)); }
}
template <int S> __device__ __forceinline__ void fixup_ff1(const float* part, const u64* ssq, bf16* F, int gw, int NGW, int lane) {
    for (int it = gw; it < 32 * 256; it += 2 * NGW) {
        const int it2 = (it + NGW < 32 * 256) ? it + NGW : it;
        const int pn = it >> 8, r = it & 255, pn2 = it2 >> 8, r2 = it2 & 255;
        const bf16* pp = (const bf16*)part + (size_t)(pn * S) * 65536 + r * 256 + 4 * lane;
        const bf16* pq = (const bf16*)part + (size_t)(pn2 * S) * 65536 + r2 * 256 + 4 * lane;
        f32x4 v[S], w2[S];
#pragma unroll
        for (int sp = 0; sp < S; ++sp) { v[sp] = ld_part4(pp + (size_t)sp * 65536); w2[sp] = ld_part4(pq + (size_t)sp * 65536); }
        const float rs = rsqrtf(fx2f(ssq[NPT + r]) * (1.0f / DM) + RMS_EPS), rs2 = rsqrtf(fx2f(ssq[NPT + r2]) * (1.0f / DM) + RMS_EPS);
        f32x4 a = v[0], c = w2[0];
#pragma unroll
        for (int sp = 1; sp < S; ++sp) { a += v[sp]; c += w2[sp]; }
#pragma unroll
        for (int k = 0; k < 4; ++k) { const float t = fmaxf(a[k] * rs, 0.f); a[k] = t * t; const float u = fmaxf(c[k] * rs2, 0.f); c[k] = u * u; }
        st_wt8(F + (size_t)(NPT + r) * FFD + pn * 256 + 4 * lane, pk(a[0], a[1]), pk(a[2], a[3]));
        st_wt8(F + (size_t)(NPT + r2) * FFD + pn2 * 256 + 4 * lane, pk(c[0], c[1]), pk(c[2], c[3]));
    }
}
template <int S> __device__ __forceinline__ void fixup_merge(const float* part, const bf16* ga, const bf16* gm, bf16* mg, int gw, int NGW, int lane) {
    for (int it = gw; it < 8 * 256; it += NGW) { const int pn = it >> 8, r = it & 255;
        const bf16* pp = (const bf16*)part + (size_t)(pn * 2 * S) * 65536 + r * 256 + 4 * lane;
        f32x4 v[2 * S];
#pragma unroll
        for (int sp = 0; sp < 2 * S; ++sp) v[sp] = ld_part4(pp + (size_t)sp * 65536);
        f32x4 a = v[0], b = v[S];
#pragma unroll
        for (int sp = 1; sp < S; ++sp) { a += v[sp]; b += v[S + sp]; }
        const size_t off = (size_t)(NPT + r) * DM + pn * 256 + 4 * lane;
        const unsigned b1 = *(const unsigned*)((const unsigned char*)ga + off), b2 = *(const unsigned*)((const unsigned char*)gm + off);
        float o[4];
#pragma unroll
        for (int k = 0; k < 4; ++k) o[k] = ((float)((b1 >> (8 * k)) & 0xffu) * a[k] + (float)((b2 >> (8 * k)) & 0xffu) * b[k]) * (1.0f / 255.0f);
        st_wt8(mg + off, pk(o[0], o[1]), pk(o[2], o[3])); }
}
__device__ __forceinline__ int tid_now() { int t = threadIdx.x; asm volatile("" : "+v"(t)); return t; }
__device__ __forceinline__ void split_arrive(unsigned* ctr) {
    asm volatile("s_waitcnt vmcnt(0)" ::: "memory");
    __syncthreads();
    if (tid_now() == 0) (void)__hip_atomic_fetch_add(ctr, 1u, __ATOMIC_RELAXED, __HIP_MEMORY_SCOPE_AGENT);
}
__device__ __forceinline__ void split_wait(unsigned* ctr, unsigned G) {
    if (tid_now() == 0) { while (__hip_atomic_load(ctr, __ATOMIC_RELAXED, __HIP_MEMORY_SCOPE_AGENT) < G) __builtin_amdgcn_s_sleep(2);
        asm volatile("s_waitcnt vmcnt(0)" ::: "memory"); }
    __syncthreads();
}

__device__ __forceinline__ void p0_transpose_item(const float* W, const float* gk, int K, int N, bf16* WT, LAS float* scr, int item, int lane) {
    const int nblk = N / 64, kb = item / nblk, nb = item - kb * nblk, k0 = 64 * kb, n0 = 64 * nb;
    const int r4 = lane >> 4, c4 = (lane & 15) * 4;
    f32x4 v[16];
#pragma unroll
    for (int i = 0; i < 16; ++i) v[i] = __builtin_nontemporal_load((const f32x4*)(W + (size_t)(k0 + r4 + 4 * i) * N + n0 + c4));
    if (gk) {
#pragma unroll
        for (int i = 0; i < 16; ++i) v[i] *= gk[k0 + r4 + 4 * i];
    }
#pragma unroll
    for (int i = 0; i < 16; ++i) { LAS float* d = scr + (r4 + 4 * i) * 65 + c4; d[0] = v[i][0]; d[1] = v[i][1]; d[2] = v[i][2]; d[3] = v[i][3]; }
    asm volatile("s_waitcnt lgkmcnt(0)" ::: "memory");
    const int c = lane & 7;
#pragma unroll
    for (int j = 0; j < 8; ++j) { const int n = (lane >> 3) + 8 * j; const LAS float* s = scr + (8 * c) * 65 + n;
        u32x4 o; o.x = pk(s[0 * 65], s[1 * 65]); o.y = pk(s[2 * 65], s[3 * 65]); o.z = pk(s[4 * 65], s[5 * 65]); o.w = pk(s[6 * 65], s[7 * 65]);
        *(u32x4*)(WT + (size_t)(n0 + n) * K + k0 + 8 * c) = o; }
    asm volatile("s_waitcnt lgkmcnt(0)" ::: "memory");
}
__device__ __forceinline__ void phase0(const Params& p, LAS unsigned char* lds, int G, int bid, int tid, int wave, int lane) {
    LAS float* scr = (LAS float*)(lds + wave * 16640);
    const int gw = bid * 8 + wave, NGW = G * 8;
    constexpr int I_IN = (DM / 64) * (INC / 64), I_AU = (AW / 64) * (DM / 64), I_OUT = (DM / 64) * (DM / 64), I_1 = (DM / 64) * (FFD / 64), I_2 = (FFD / 64) * (DM / 64);
    constexpr int I_L = I_IN + 2 * I_AU + I_OUT + I_1 + I_2;
    for (int it = gw; it < NLAYER * I_L; it += NGW) {
        const int lq = it / I_L, l = NLAYER - 1 - lq; int r = it - lq * I_L;
        if (r < I_IN) { p0_transpose_item(p.w_in + (size_t)l * DM * INC, p.norm1_g + l * DM, DM, INC, (bf16*)(p.ws + WS_WIN) + (size_t)l * INC * DM, scr, r, lane); continue; } r -= I_IN;
        if (r < I_AU) { p0_transpose_item(p.w_au + (size_t)l * AW * DM, nullptr, 2 * AW, DM, (bf16*)(p.ws + WS_WAU) + (size_t)l * DM * 2 * AW, scr, r, lane); continue; } r -= I_AU;
        if (r < I_AU) { p0_transpose_item(p.w_su + (size_t)l * AW * DM, nullptr, 2 * AW, DM, (bf16*)(p.ws + WS_WAU) + (size_t)l * DM * 2 * AW + AW, scr, r, lane); continue; } r -= I_AU;
        if (r < I_OUT) { p0_transpose_item(p.w_out + (size_t)l * DM * DM, nullptr, DM, DM, (bf16*)(p.ws + WS_WOUT) + (size_t)l * DM * DM, scr, r, lane); continue; } r -= I_OUT;
        if (r < I_1) { p0_transpose_item(p.w_ff1 + (size_t)l * DM * FFD, p.norm2_g + l * DM, DM, FFD, (bf16*)(p.ws + WS_W1) + (size_t)l * FFD * DM, scr, r, lane); continue; } r -= I_1;
        p0_transpose_item(p.w_ff2 + (size_t)l * FFD * DM, nullptr, FFD, DM, (bf16*)(p.ws + WS_W2) + (size_t)l * DM * FFD, scr, r, lane);
    }
    u64* st = (u64*)(p.ws + WS_STAT);
    bf16* XB = (bf16*)(p.ws + WS_XB);
    for (int m = gw; m < MTOK; m += NGW) {
        const float* xr = m < NPT ? p.x_prompt + (size_t)m * DM : p.x_sample + (size_t)(m - NPT) * DM;
        f32x4 v[8]; float s = 0.f;
#pragma unroll
        for (int j = 0; j < 8; ++j) { v[j] = ((const f32x4*)xr)[lane + 64 * j]; s += (v[j][0] * v[j][0] + v[j][1] * v[j][1]) + (v[j][2] * v[j][2] + v[j][3] * v[j][3]); }
        s = wave_sum(s);
#pragma unroll
        for (int j = 0; j < 8; ++j) { u32x2 w; w.x = pk(v[j][0], v[j][1]); w.y = pk(v[j][2], v[j][3]); ((u32x2*)(XB + (size_t)m * DM))[lane + 64 * j] = w; }
        if (lane == 0) st[m] = f2fx(s);
    }
    for (int i = bid * 512 + tid; i < 16 * MTOK; i += G * 512) if (i >= MTOK) st[i] = 0ull;
}

constexpr int KS_LD = 72, VT_LD = 260, VT_OFF = 256 * KS_LD * 2;
__device__ __forceinline__ void rope_cs(float pos, int fi, float& c, float& s) {
    const float inv = __builtin_amdgcn_exp2f(-(float)fi * (13.287712379549449f / 32.0f));
    const float ang = pos * inv;
    const float n = rintf(ang * 0.15915494309189535f);
    float r = fmaf(-n, 6.2831854820251465f, ang);
    r = fmaf(n, 1.7484555e-7f, r);
    s = __sinf(r); c = __cosf(r);
}
__device__ __forceinline__ void stage_k_row(const bf16* kraw, bool valid, float pos, int sub, const float* kg, LAS bf16* ksrow, float* kout) {
    u32x4 a0 = {0u, 0u, 0u, 0u}, a1 = a0, b0 = a0, b1 = a0;
    if (valid) { const u32x4* s = (const u32x4*)(kraw + 16 * sub); a0 = s[0]; a1 = s[1]; const u32x4* t = (const u32x4*)(kraw + 32 + 16 * sub); b0 = t[0]; b1 = t[1]; }
    float x1[16], x2[16];
    unpack8(a0, x1); unpack8(a1, x1 + 8); unpack8(b0, x2); unpack8(b1, x2 + 8);
    float ss = 0.f;
#pragma unroll
    for (int i = 0; i < 16; ++i) ss += x1[i] * x1[i] + x2[i] * x2[i];
    ss += __shfl_xor(ss, 1);
    const float rstd = rsqrtf(ss * (1.0f / 64.0f) + RMS_EPS);
    float o1[16], o2[16];
#pragma unroll
    for (int i = 0; i < 16; ++i) { const int fi = 16 * sub + i; float c, s; rope_cs(pos, fi, c, s);
        const float y1 = x1[i] * rstd * kg[fi], y2 = x2[i] * rstd * kg[32 + fi]; o1[i] = y1 * c - y2 * s; o2[i] = y2 * c + y1 * s; }
    *(LAS u32x4*)(ksrow + 16 * sub) = pack8(o1); *(LAS u32x4*)(ksrow + 16 * sub + 8) = pack8(o1 + 8);
    *(LAS u32x4*)(ksrow + 32 + 16 * sub) = pack8(o2); *(LAS u32x4*)(ksrow + 32 + 16 * sub + 8) = pack8(o2 + 8);
    if (kout != nullptr && valid) {
#pragma unroll
        for (int i = 0; i < 4; ++i) { ((f32x4*)(kout + 16 * sub))[i] = (f32x4){o1[4 * i], o1[4 * i + 1], o1[4 * i + 2], o1[4 * i + 3]};
            ((f32x4*)(kout + 32 + 16 * sub))[i] = (f32x4){o2[4 * i], o2[4 * i + 1], o2[4 * i + 2], o2[4 * i + 3]}; }
    }
}
__device__ __forceinline__ void q_frag_from_raw(const u32x4 a, const u32x4 b, float pos, int g, const float* qg, bf16x8& qf0, bf16x8& qf1) {
    float x1[8], x2[8]; unpack8(a, x1); unpack8(b, x2);
    float ss = 0.f;
#pragma unroll
    for (int i = 0; i < 8; ++i) ss += x1[i] * x1[i] + x2[i] * x2[i];
    ss += __shfl_xor(ss, 16); ss += __shfl_xor(ss, 32);
    const float rstd = rsqrtf(ss * (1.0f / 64.0f) + RMS_EPS) * (0.125f * 1.4426950408889634f);
    float o1[8], o2[8];
#pragma unroll
    for (int i = 0; i < 8; ++i) { const int fi = 8 * g + i; float c, s; rope_cs(pos, fi, c, s);
        const float y1 = x1[i] * rstd * qg[fi], y2 = x2[i] * rstd * qg[32 + fi]; o1[i] = y1 * c - y2 * s; o2[i] = y2 * c + y1 * s; }
    qf0 = __builtin_bit_cast(bf16x8, pack8(o1)); qf1 = __builtin_bit_cast(bf16x8, pack8(o2));
}
__device__ __forceinline__ void load_q_frag(const bf16* qraw, float pos, int g, const float* qg, bf16x8& qf0, bf16x8& qf1) {
    const u32x4 a = *(const u32x4*)(qraw + 8 * g), b = *(const u32x4*)(qraw + 32 + 8 * g);
    q_frag_from_raw(a, b, pos, g, qg, qf0, qf1);
}
template <int PAR> __device__ __forceinline__ void attn_group(const LAS bf16* KS, const LAS bf16* VT, bf16x8 qf0, bf16x8 qf1, int c0, int qrel, int rmin, float sink2, bf16* orow, int lane) {
    const int r16 = lane & 15, g = lane >> 4, d = 4 * g - qrel;
    f32x4 sc[10];
    float mx = sink2;
#pragma unroll
    for (int tt = 0; tt < 10; ++tt) {
        constexpr int dummy = 0; (void)dummy;
        const int r = tt - PAR;
        if (r < 0 || r > 8) { sc[tt] = (f32x4){0.f, 0.f, 0.f, 0.f}; continue; }
        const LAS bf16* kp = KS + (32 * c0 + 16 * tt + r16) * KS_LD + 8 * g;
        const bf16x8 k0 = *(const LAS bf16x8*)kp, k1 = *(const LAS bf16x8*)(kp + 32);
        f32x4 a = {0.f, 0.f, 0.f, 0.f};
        a = __builtin_amdgcn_mfma_f32_16x16x32_bf16(k0, qf0, a, 0, 0, 0);
        a = __builtin_amdgcn_mfma_f32_16x16x32_bf16(k1, qf1, a, 0, 0, 0);
        if (r < rmin) a = (f32x4){-1e30f, -1e30f, -1e30f, -1e30f};
        else if (r == 0) {
#pragma unroll
            for (int q = 0; q < 4; ++q) a[q] = (d + q > 0) ? a[q] : -1e30f;
        } else if (r == 8) {
#pragma unroll
            for (int q = 0; q < 4; ++q) a[q] = (d + q <= 0) ? a[q] : -1e30f;
        }
        sc[tt] = a;
        mx = fmaxf(fmaxf(mx, fmaxf(a[0], a[1])), fmaxf(a[2], a[3]));
    }
    mx = fmaxf(mx, __shfl_xor(mx, 16)); mx = fmaxf(mx, __shfl_xor(mx, 32));
    float sum = 0.f;
#pragma unroll
    for (int tt = 0; tt < 10; ++tt) {
        const int r = tt - PAR;
        if (r < 0 || r > 8) continue;
#pragma unroll
        for (int q = 0; q < 4; ++q) { const float pz = __builtin_amdgcn_exp2f(sc[tt][q] - mx); sc[tt][q] = pz; sum += pz; }
    }
    sum += __shfl_xor(sum, 16); sum += __shfl_xor(sum, 32);
    const float inv = 1.0f / (sum + __builtin_amdgcn_exp2f(sink2 - mx));
    f32x4 o[4];
#pragma unroll
    for (int dt = 0; dt < 4; ++dt) o[dt] = (f32x4){0.f, 0.f, 0.f, 0.f};
#pragma unroll
    for (int cc = 0; cc < 5; ++cc) {
        u32x4 pw; pw.x = pk(sc[2 * cc][0], sc[2 * cc][1]); pw.y = pk(sc[2 * cc][2], sc[2 * cc][3]); pw.z = pk(sc[2 * cc + 1][0], sc[2 * cc + 1][1]); pw.w = pk(sc[2 * cc + 1][2], sc[2 * cc + 1][3]);
        const bf16x8 pf = __builtin_bit_cast(bf16x8, pw);
#pragma unroll
        for (int dt = 0; dt < 4; ++dt) {
            const LAS bf16* vp = VT + (16 * dt + r16) * VT_LD + 32 * (c0 + cc) + 4 * g;
            const u32x2 lo = *(const LAS u32x2*)vp, hi = *(const LAS u32x2*)(vp + 16);
            u32x4 vw; vw.x = lo.x; vw.y = lo.y; vw.z = hi.x; vw.w = hi.y;
            o[dt] = __builtin_amdgcn_mfma_f32_16x16x32_bf16(__builtin_bit_cast(bf16x8, vw), pf, o[dt], 0, 0, 0);
        }
    }
#pragma unroll
    for (int dt = 0; dt < 4; ++dt) { const f32x4 v = o[dt] * inv; u32x2 w; w.x = pk(v[0], v[1]); w.y = pk(v[2], v[3]); *(u32x2*)(orow + 16 * dt + 4 * g) = w; }
}
template <int PAR> __device__ __forceinline__ void attn_prompt_wave(const LAS bf16* KS, const LAS bf16* VT, const u32x4 (&qa)[4], const u32x4 (&qbw)[4], const float* qg, const float* sinks, int kvh, int qb, int wave, bf16* orow0, int lane) {
    const int g = lane >> 4, tokq = qb * 128 + 16 * wave + (lane & 15);
    float cs[8], sn[8], g1[8], g2[8];
#pragma unroll
    for (int i = 0; i < 8; ++i) { rope_cs((float)tokq, 8 * g + i, cs[i], sn[i]); g1[i] = qg[8 * g + i]; g2[i] = qg[32 + 8 * g + i]; }
#pragma unroll
    for (int hg = 0; hg < 4; ++hg) {
        float x1[8], x2[8]; unpack8(qa[hg], x1); unpack8(qbw[hg], x2);
        float ss = 0.f;
#pragma unroll
        for (int i = 0; i < 8; ++i) ss += x1[i] * x1[i] + x2[i] * x2[i];
        ss += __shfl_xor(ss, 16); ss += __shfl_xor(ss, 32);
        const float rstd = rsqrtf(ss * (1.0f / 64.0f) + RMS_EPS) * (0.125f * 1.4426950408889634f);
        float o1[8], o2[8];
#pragma unroll
        for (int i = 0; i < 8; ++i) { const float y1 = x1[i] * rstd * g1[i], y2 = x2[i] * rstd * g2[i]; o1[i] = y1 * cs[i] - y2 * sn[i]; o2[i] = y2 * cs[i] + y1 * sn[i]; }
        const bf16x8 qf0 = __builtin_bit_cast(bf16x8, pack8(o1)), qf1 = __builtin_bit_cast(bf16x8, pack8(o2));
        attn_group<PAR>(KS, VT, qf0, qf1, wave >> 1, lane & 15, qb > 0 ? 0 : 8 - wave, sinks[kvh * 4 + hg] * 1.4426950408889634f, orow0 + hg * 64, lane);
    }
}
__device__ __forceinline__ void attn_prompt_unit(const Params& p, int l, int unit, LAS unsigned char* lds, int tid, int wave, int lane) {
    asm volatile("" : "+v"(tid), "+v"(lane));
    const int b = unit >> 7, qb = (unit >> 2) & 31, kvh = unit & 3;
    LAS bf16* KS = (LAS bf16*)lds; LAS bf16* VT = (LAS bf16*)(lds + VT_OFF);
    const bf16* QKV = (const bf16*)(p.ws + WS_QKV); bf16* AO = (bf16*)(p.ws + WS_AO);
    const float* kg = p.k_norm_g + l * 64; const float* qg = p.q_norm_g + l * 64;
    const size_t qrow = (size_t)b * SEQ + qb * 128 + 16 * wave + (lane & 15);
    u32x4 qa[4], qbw[4];
#pragma unroll
    for (int hg = 0; hg < 4; ++hg) { const bf16* qraw = QKV + qrow * QKVW + (kvh * 4 + hg) * 64; qa[hg] = *(const u32x4*)(qraw + 8 * (lane >> 4)); qbw[hg] = *(const u32x4*)(qraw + 32 + 8 * (lane >> 4)); }
    u32x4 vw[4];
#pragma unroll
    for (int i = 0; i < 4; ++i) { const int c = tid + 512 * i, key = c >> 3, dch = c & 7, tok = qb * 128 - 128 + key;
        vw[i] = (u32x4){0u, 0u, 0u, 0u};
        if (tok >= 0) vw[i] = *(const u32x4*)(QKV + (size_t)(b * SEQ + tok) * QKVW + 1280 + kvh * 64 + 8 * dch); }
    { const int key = tid >> 1, sub = tid & 1, tok = qb * 128 - 128 + key; const bool valid = tok >= 0;
      const bf16* kraw = QKV + (size_t)(b * SEQ + (valid ? tok : 0)) * QKVW + 1024 + kvh * 64;
      float* kout = (qb == 31 && key >= 128) ? p.out + O_KP + ((size_t)((l * 2 + b) * 128 + (key - 128)) * 4 + kvh) * 64 : nullptr;
      stage_k_row(kraw, valid, (float)tok, sub, kg, KS + key * KS_LD, kout); }
#pragma unroll
    for (int i = 0; i < 4; ++i) {
        const int c = tid + 512 * i, key = c >> 3, dch = c & 7; const u32x4 w = vw[i];
        LAS bf16* vp = VT + (8 * dch) * VT_LD + key;
        vp[0] = (bf16)(w.x & 0xffffu); vp[VT_LD] = (bf16)(w.x >> 16); vp[2 * VT_LD] = (bf16)(w.y & 0xffffu); vp[3 * VT_LD] = (bf16)(w.y >> 16);
        vp[4 * VT_LD] = (bf16)(w.z & 0xffffu); vp[5 * VT_LD] = (bf16)(w.z >> 16); vp[6 * VT_LD] = (bf16)(w.w & 0xffffu); vp[7 * VT_LD] = (bf16)(w.w >> 16);
        if (qb == 31 && key >= 128) { float f[8]; unpack8(w, f); float* vo = p.out + O_VP + ((size_t)((l * 2 + b) * 128 + (key - 128)) * 4 + kvh) * 64 + 8 * dch;
            *(f32x4*)vo = (f32x4){f[0], f[1], f[2], f[3]}; *(f32x4*)(vo + 4) = (f32x4){f[4], f[5], f[6], f[7]}; }
    }
    __syncthreads();
    bf16* orow0 = AO + qrow * (2 * AW) + kvh * 256;
    if (wave & 1) attn_prompt_wave<1>(KS, VT, qa, qbw, qg, p.sinks + l * 16, kvh, qb, wave, orow0, lane);
    else attn_prompt_wave<0>(KS, VT, qa, qbw, qg, p.sinks + l * 16, kvh, qb, wave, orow0, lane);
}
__device__ __forceinline__ void attn_sample_unit(const Params& p, int l, int unit, LAS unsigned char* lds, int tid, int wave, int lane) {
    asm volatile("" : "+v"(tid), "+v"(lane));
    const int s = unit >> 2, kvh = unit & 3;
    LAS bf16* KS = (LAS bf16*)lds; LAS bf16* VT = (LAS bf16*)(lds + VT_OFF);
    const bf16* QKV = (const bf16*)(p.ws + WS_QKV); bf16* AO = (bf16*)(p.ws + WS_AO);
    const float* kg = p.k_norm_g + l * 64; const float* qg = p.q_norm_g + l * 64;
    const size_t cbase = ((size_t)l * 32 + s) * 128;
    const int qn = lane & 15, qt = qn & 7, qhead = kvh * 4 + 2 * (wave & 1) + (qn >> 3); const size_t qrow = (size_t)NPT + s * 8 + qt;
    const u32x4 qra = *(const u32x4*)(QKV + qrow * QKVW + qhead * 64 + 8 * (lane >> 4)), qrb = *(const u32x4*)(QKV + qrow * QKVW + qhead * 64 + 32 + 8 * (lane >> 4));
    const float qsink = p.sinks[l * 16 + qhead];
    { const int key = tid >> 2, dq = tid & 3; const float* src = p.cache_k + ((cbase + key) * 4 + kvh) * 64 + 16 * dq;
      f32x4 a[4];
#pragma unroll
      for (int i = 0; i < 4; ++i) a[i] = ((const f32x4*)src)[i];
      u32x4 w0, w1; w0.x = pk(a[0][0], a[0][1]); w0.y = pk(a[0][2], a[0][3]); w0.z = pk(a[1][0], a[1][1]); w0.w = pk(a[1][2], a[1][3]);
      w1.x = pk(a[2][0], a[2][1]); w1.y = pk(a[2][2], a[2][3]); w1.z = pk(a[3][0], a[3][1]); w1.w = pk(a[3][2], a[3][3]);
      *(LAS u32x4*)(KS + key * KS_LD + 16 * dq) = w0; *(LAS u32x4*)(KS + key * KS_LD + 16 * dq + 8) = w1;
      if (key >= 8) { float* dst = p.out + O_KS + ((cbase + key - 8) * 4 + kvh) * 64 + 16 * dq;
#pragma unroll
          for (int i = 0; i < 4; ++i) ((f32x4*)dst)[i] = a[i]; } }
    if (tid < 16) { const int t = tid >> 1, sub = tid & 1;
        stage_k_row(QKV + (size_t)(NPT + s * 8 + t) * QKVW + 1024 + kvh * 64, true, (float)(16384 + t), sub, kg, KS + (128 + t) * KS_LD, p.out + O_KS + ((cbase + 120 + t) * 4 + kvh) * 64); }
    if (tid >= 64 && tid < 64 + 96) { const int idx = tid - 64, rowk = 136 + (idx >> 2), dq = idx & 3; const u32x4 z = {0u, 0u, 0u, 0u};
        *(LAS u32x4*)(KS + rowk * KS_LD + 16 * dq) = z; *(LAS u32x4*)(KS + rowk * KS_LD + 16 * dq + 8) = z; }
#pragma unroll
    for (int i = 0; i < 4; ++i) {
        const int c = tid + 512 * i, key = c >> 4, dq = c & 15;
        const f32x4 a = *(const f32x4*)(p.cache_v + ((cbase + key) * 4 + kvh) * 64 + 4 * dq);
        const unsigned w0 = pk(a[0], a[1]), w1 = pk(a[2], a[3]);
        LAS bf16* vp = VT + (4 * dq) * VT_LD + key;
        vp[0] = (bf16)(w0 & 0xffffu); vp[VT_LD] = (bf16)(w0 >> 16); vp[2 * VT_LD] = (bf16)(w1 & 0xffffu); vp[3 * VT_LD] = (bf16)(w1 >> 16);
        if (key >= 8) *(f32x4*)(p.out + O_VSAMP + ((cbase + key - 8) * 4 + kvh) * 64 + 4 * dq) = a;
    }
    if (tid < 64) { const int t = tid >> 3, dch = tid & 7;
        const u32x4 w = *(const u32x4*)(QKV + (size_t)(NPT + s * 8 + t) * QKVW + 1280 + kvh * 64 + 8 * dch);
        LAS bf16* vp = VT + (8 * dch) * VT_LD + 128 + t;
        vp[0] = (bf16)(w.x & 0xffffu); vp[VT_LD] = (bf16)(w.x >> 16); vp[2 * VT_LD] = (bf16)(w.y & 0xffffu); vp[3 * VT_LD] = (bf16)(w.y >> 16);
        vp[4 * VT_LD] = (bf16)(w.z & 0xffffu); vp[5 * VT_LD] = (bf16)(w.z >> 16); vp[6 * VT_LD] = (bf16)(w.w & 0xffffu); vp[7 * VT_LD] = (bf16)(w.w >> 16);
        float f[8]; unpack8(w, f); float* vo = p.out + O_VSAMP + ((cbase + 120 + t) * 4 + kvh) * 64 + 8 * dch;
        *(f32x4*)vo = (f32x4){f[0], f[1], f[2], f[3]}; *(f32x4*)(vo + 4) = (f32x4){f[4], f[5], f[6], f[7]};
    } else if (tid < 128) { const int d = tid - 64; LAS unsigned* zp = (LAS unsigned*)(VT + d * VT_LD + 136);
#pragma unroll
        for (int i = 0; i < 12; ++i) zp[i] = 0u; }
    __syncthreads();
    if (wave < 2) {
        bf16x8 qf0, qf1; q_frag_from_raw(qra, qrb, (float)(16384 + qt), lane >> 4, qg, qf0, qf1);
        attn_group<0>(KS, VT, qf0, qf1, 0, qt, 0, qsink * 1.4426950408889634f, AO + qrow * (2 * AW) + qhead * 64, lane);
    }
}
constexpr int SG_LD = 136, SG_WOFF = 128 * SG_LD * 2;
__device__ __forceinline__ void sgu_prompt_unit(const Params& p, int l, int unit, LAS unsigned char* lds, int tid, int wave, int lane, bool stage_w) {
    asm volatile("" : "+v"(tid), "+v"(lane));
    const int b = unit >> 8, n = (unit >> 3) & 31, grp = unit & 7;
    LAS bf16* VNT = (LAS bf16*)lds; LAS bf16* WL = (LAS bf16*)(lds + SG_WOFF);
    const bf16* VS = (const bf16*)(p.ws + WS_VS); const bf16* U = (const bf16*)(p.ws + WS_U); bf16* MO = (bf16*)(p.ws + WS_AO) + AW;
    const u64* vst = (const u64*)(p.ws + WS_STAT) + 8 * MTOK + (size_t)l * 2 * MTOK;
    const size_t row0 = (size_t)b * SEQ + n * 128;
    u32x2 upre[8];
#pragma unroll
    for (int ct = 0; ct < 8; ++ct) upre[ct] = *(const u32x2*)(U + (row0 + 16 * wave + (lane & 15)) * 1024 + grp * 128 + 16 * ct + 4 * (lane >> 4));
    if (stage_w) { const int t = tid >> 2, q4 = tid & 3; const float* src = p.sgu_w + (((size_t)l * 8 + grp) * 128 + t) * 128 + 32 * q4;
#pragma unroll
      for (int k = 0; k < 4; ++k) { const f32x4 a = ((const f32x4*)src)[2 * k], bb = ((const f32x4*)src)[2 * k + 1]; const int s0 = 32 * q4 + 8 * k; float f[8];
#pragma unroll
          for (int i = 0; i < 4; ++i) { f[i] = (s0 + i <= t) ? a[i] : 0.f; f[4 + i] = (s0 + 4 + i <= t) ? bb[i] : 0.f; }
          *(LAS u32x4*)(WL + t * SG_LD + s0) = pack8(f); } }
#pragma unroll
    for (int i = 0; i < 4; ++i) {
        const int c = tid + 512 * i, sr = c >> 4, cch = c & 15; const size_t row = row0 + sr;
        const u32x4 w = *(const u32x4*)(VS + row * 1024 + grp * 128 + 8 * cch);
        const float s1 = fx2f(vst[2 * row]), s2 = fx2f(vst[2 * row + 1]), mean = s1 * (1.0f / 1024.0f), var = s2 * (1.0f / 1024.0f) - mean * mean, rstd = rsqrtf(var + LN_EPS);
        const float* gp = p.ln_g + l * 1024 + grp * 128 + 8 * cch; const float* bp = p.ln_b + l * 1024 + grp * 128 + 8 * cch;
        const f32x4 g0 = *(const f32x4*)gp, g1 = *(const f32x4*)(gp + 4), b0 = *(const f32x4*)bp, b1 = *(const f32x4*)(bp + 4);
        float x[8]; unpack8(w, x);
        LAS bf16* vp = VNT + (8 * cch) * SG_LD + (((sr >> 3) ^ cch) << 3) + (sr & 7);
#pragma unroll
        for (int k = 0; k < 4; ++k) { const float v0 = (x[k] - mean) * rstd * g0[k] + b0[k], v1 = (x[4 + k] - mean) * rstd * g1[k] + b1[k];
            vp[k * SG_LD] = (bf16)(pk(v0, 0.f) & 0xffffu); vp[(4 + k) * SG_LD] = (bf16)(pk(v1, 0.f) & 0xffffu); }
    }
    __syncthreads();
    const int t0 = 16 * wave, r16 = lane & 15, g = lane >> 4;
    f32x4 acc[8];
#pragma unroll
    for (int ct = 0; ct < 8; ++ct) acc[ct] = (f32x4){0.f, 0.f, 0.f, 0.f};
    const int nks = (wave >> 1) + 1;
    for (int ks = 0; ks < nks; ++ks) {
        const bf16x8 wb = *(const LAS bf16x8*)(WL + (t0 + r16) * SG_LD + 32 * ks + 8 * g);
#pragma unroll
        for (int ct = 0; ct < 8; ++ct) { const bf16x8 va = *(const LAS bf16x8*)(VNT + (16 * ct + r16) * SG_LD + (((4 * ks + g) ^ (2 * ct + (r16 >> 3))) << 3));
            acc[ct] = __builtin_amdgcn_mfma_f32_16x16x32_bf16(va, wb, acc[ct], 0, 0, 0); }
    }
    const int t = t0 + r16; const float bias = p.sgu_b[(l * 8 + grp) * 128 + t]; const size_t row = row0 + t;
#pragma unroll
    for (int ct = 0; ct < 8; ++ct) { const int ch = grp * 128 + 16 * ct + 4 * g; const u32x2 uw = upre[ct];
        u32x2 o; o.x = pk(bf_lo(uw.x) * (acc[ct][0] + bias), bf_hi(uw.x) * (acc[ct][1] + bias)); o.y = pk(bf_lo(uw.y) * (acc[ct][2] + bias), bf_hi(uw.y) * (acc[ct][3] + bias));
        *(u32x2*)(MO + row * (2 * AW) + ch) = o; }
}
__device__ __forceinline__ void sgu_sample_unit(const Params& p, int l, int s, int tid) {
    asm volatile("" : "+v"(tid));
    const bf16* VS = (const bf16*)(p.ws + WS_VS); const bf16* U = (const bf16*)(p.ws + WS_U); bf16* MO = (bf16*)(p.ws + WS_AO) + AW;
    const u64* vst = (const u64*)(p.ws + WS_STAT) + 8 * MTOK + (size_t)l * 2 * MTOK;
    const size_t row0 = (size_t)NPT + s * 8; const int ch = 2 * tid, grp = ch >> 7;
    const float g0 = p.ln_g[l * 1024 + ch], g1 = p.ln_g[l * 1024 + ch + 1], b0 = p.ln_b[l * 1024 + ch], b1 = p.ln_b[l * 1024 + ch + 1];
    float vn0[8], vn1[8];
#pragma unroll
    for (int t = 0; t < 8; ++t) { const size_t row = row0 + t; const unsigned w = *(const unsigned*)(VS + row * 1024 + ch);
        const float s1 = fx2f(vst[2 * row]), s2 = fx2f(vst[2 * row + 1]), mean = s1 * (1.0f / 1024.0f), var = s2 * (1.0f / 1024.0f) - mean * mean, rstd = rsqrtf(var + LN_EPS);
        vn0[t] = (bf_lo(w) - mean) * rstd * g0 + b0; vn1[t] = (bf_hi(w) - mean) * rstd * g1 + b1;
        *(f32x2*)(p.out + O_SGUV + (((size_t)l * 32 + s) * 8 + t) * 1024 + ch) = (f32x2){vn0[t], vn1[t]}; }
    const float* wg = p.sgu_w + ((size_t)l * 8 + grp) * 128 * 128; const float* bg = p.sgu_b + (l * 8 + grp) * 128;
#pragma unroll
    for (int t = 0; t < 8; ++t) { float m0 = bg[t], m1 = m0;
#pragma unroll
        for (int sp = 0; sp <= t; ++sp) { const float w = wg[t * 128 + sp]; m0 += w * vn0[sp]; m1 += w * vn1[sp]; }
        const size_t row = row0 + t; const unsigned uw = *(const unsigned*)(U + row * 1024 + ch);
        *(unsigned*)(MO + row * (2 * AW) + ch) = pk(bf_lo(uw) * m0, bf_hi(uw) * m1); }
}
__device__ __forceinline__ void phase2(const Params& p, int l, LAS unsigned char* lds, int G, int bid, int tid, int wave, int lane) {
    for (int it = bid; it < 256; it += G) { __syncthreads(); attn_prompt_unit(p, l, it, lds, tid, wave, lane); }
    for (int it = bid, k = 0; it < 512; it += G, ++k) { __syncthreads(); sgu_prompt_unit(p, l, it, lds, tid, wave, lane, k == 0 || (G & 7) != 0); }
    for (int it = bid; it < 128; it += G) { __syncthreads(); attn_sample_unit(p, l, it, lds, tid, wave, lane); }
    for (int it = (bid + G - 128 % G) % G; it < 32; it += G) sgu_sample_unit(p, l, it, tid);
    __syncthreads();
}

#define XB_TMO      128
#define XB_XCNT(j)  (256  + 64 * (j))
#define XB_XSUB(j)  (1280 + 64 * (j))
#define XB_XGEN(j)  (2304 + 64 * (j))
#define XB_TOP      3328
#define XB_TOPGEN   3392
#define XCD_BAR_WORDS 3456
#define XB_SPIN_CAP (1u << 18)

__device__ __forceinline__ unsigned xb_ld(unsigned* p)              { return __hip_atomic_load(p, __ATOMIC_RELAXED, __HIP_MEMORY_SCOPE_AGENT); }
__device__ __forceinline__ unsigned xb_add(unsigned* p, unsigned v) { return __hip_atomic_fetch_add(p, v, __ATOMIC_RELAXED, __HIP_MEMORY_SCOPE_AGENT); }
__device__ __forceinline__ unsigned xb_xcc_id() { return (unsigned)__builtin_amdgcn_s_getreg((3 << 11) | 20) & 0xFu; }
#define XB_SPIN(cond, bar) do { unsigned _sp = 0; while (cond) { __builtin_amdgcn_s_sleep(1); \
    if ((++_sp & 255u) == 0u) { if (xb_ld(&(bar)[XB_TMO])) break; if (_sp > XB_SPIN_CAP) { atomicAdd(&(bar)[XB_TMO], 1u); break; } } } } while (0)

struct XcdBarrier {
    unsigned* bar; unsigned x;
    volatile LAS unsigned* st;
};

__device__ __forceinline__ XcdBarrier xcd_barrier_post(unsigned* bar, volatile LAS unsigned* st) {
    XcdBarrier b; b.bar = bar; b.x = xb_xcc_id(); b.st = st;
    if (threadIdx.x == 0) (void)xb_add(&bar[XB_XCNT(b.x)], 1u);
    return b;
}
__device__ __forceinline__ void xcd_barrier_complete(unsigned* bar, unsigned x, unsigned& nloc, unsigned& nx) {
    const unsigned G = gridDim.x * gridDim.y * gridDim.z;
    unsigned sum, cnt, mine, sp = 0u;
    for (;;) {
        sum = 0u; cnt = 0u; mine = 0u;
#pragma unroll
        for (unsigned j = 0; j < 16; ++j) { const unsigned c = xb_ld(&bar[XB_XCNT(j)]); sum += c; cnt += (c > 0u) ? 1u : 0u; mine = (j == x) ? c : mine; }
        if (sum == G) break;
        __builtin_amdgcn_s_sleep(1);
        if ((++sp & 255u) == 0u) { if (xb_ld(&bar[XB_TMO])) break; if (sp > XB_SPIN_CAP) { atomicAdd(&bar[XB_TMO], 1u); break; } }
    }
    nloc = mine > 0u ? mine : 1u; nx = cnt > 0u ? cnt : 1u;
}

__device__ __forceinline__ void xcd_barrier(const XcdBarrier& b) {
    asm volatile("s_waitcnt vmcnt(0)" ::: "memory");
    __syncthreads();
    if (tid_now() == 0) {
        unsigned* bar = b.bar; asm volatile("" : "+s"(bar)); unsigned bx = b.x; asm volatile("" : "+s"(bx));
        __builtin_amdgcn_s_waitcnt(0);
        unsigned nloc = b.st[0], nx = b.st[1];
        if (nloc == 0u) { xcd_barrier_complete(bar, bx, nloc, nx); b.st[0] = nloc; b.st[1] = nx; }
        const unsigned old = xb_add(&bar[XB_XSUB(bx)], 1u);
        const unsigned gen = old / nloc;
        if (old + 1u == (gen + 1u) * nloc) {
            __builtin_amdgcn_fence(__ATOMIC_RELEASE, "agent");
            asm volatile("s_waitcnt vmcnt(0)" ::: "memory");
            const unsigned og = xb_add(&bar[XB_TOP], 1u);
            const unsigned tg = og / nx;
            if (og + 1u == (tg + 1u) * nx) xb_add(&bar[XB_TOPGEN], 1u);
            else XB_SPIN(xb_ld(&bar[XB_TOPGEN]) == tg, bar);
            __builtin_amdgcn_fence(__ATOMIC_ACQUIRE, "agent");
            xb_add(&bar[XB_XGEN(bx)], 1u);
            asm volatile("s_waitcnt vmcnt(0)" ::: "memory");
        } else {
            XB_SPIN(xb_ld(&bar[XB_XGEN(bx)]) == gen, bar);
            __builtin_amdgcn_fence(__ATOMIC_ACQUIRE, "agent");
            asm volatile("s_waitcnt vmcnt(0)" ::: "memory");
        }
    }
    __syncthreads();
}

__device__ __forceinline__ unsigned char* launder_ws(unsigned char* w) { asm volatile("" : "+s"(w)); return w; }
__global__ void __launch_bounds__(512, 2) fwd_kernel(Params p) {
    extern __shared__ __attribute__((aligned(16))) unsigned char lds_raw[];
    LAS unsigned char* lds = (LAS unsigned char*)lds_raw;
    cg::grid_group grid = cg::this_grid();
    const int tid = threadIdx.x, lane = tid & 63, wave = __builtin_amdgcn_readfirstlane(tid >> 6);
    const int G = gridDim.x, bid = blockIdx.x;
#define WSP(T, off) ((T*)(launder_ws(p.ws) + (off)))
    volatile LAS unsigned* bst = (volatile LAS unsigned*)(lds + 147392);
    if (tid < 2) bst[tid] = 0u;
    __syncthreads();
    const XcdBarrier bar = xcd_barrier_post(WSP(unsigned, WS_BAR), bst);
#define GRID_BAR() xcd_barrier(bar)
    if (p.out == nullptr) grid.sync();
    phase0(p, lds, G, bid, tid, wave, lane);
    GRID_BAR();
    const int gw = bid * 8 + wave, NGW = G * 8;
    for (int l = 0; l < NLAYER; ++l) {
        unsigned* ctr = WSP(unsigned, WS_CNT) + l * 8;
        {
            if (l > 0) { fixup_res<16>(WSP(float, WS_PART), WSP(const bf16, WS_XB), nullptr, WSP(bf16, WS_XB), WSP(u64, WS_STAT) + (size_t)l * MTOK, gw, NGW, lane); split_arrive(ctr + 0); }
            u64* st = WSP(u64, WS_STAT);
            EpiIn E{st + (size_t)l * MTOK, WSP(bf16, WS_QKV), WSP(bf16, WS_U), WSP(bf16, WS_VS), WSP(bf16, WS_GA), WSP(bf16, WS_GM), st + 8 * MTOK + (size_t)l * 2 * MTOK};
            const bf16* win = WSP(const bf16, WS_WIN) + (size_t)l * INC * DM; const bf16* XB = WSP(const bf16, WS_XB);
            { pg8::Gemm g{XB, win, NPT, INC, DM, DM}; pg8::StaticOrder S; S.init(NPT, INC, G, bid); pg8::gemm_phase<EpiIn, pg8::StaticOrder, true, true>(lds, g, S, E); }
            if (l > 0) split_wait(ctr + 0, (unsigned)G);
            { pg8::Gemm g{XB, win, MTOK, INC, DM, DM}; const int nfull = (32 * 30) % G; MiniOrder M{(nfull + 30 <= G) ? nfull : 0, 30, 1, 0, bid}; pg8::gemm_phase<EpiIn, MiniOrder, true, true>(lds, g, M, E); }
        }
        GRID_BAR();
        phase2(p, l, lds, G, bid, tid, wave, lane);
#ifdef PROBE_P2
        phase2(p, l, lds, G, bid, tid, wave, lane);
#endif
        GRID_BAR();
        {
            const bf16* AOM = WSP(const bf16, WS_AO); const bf16* wcat = WSP(const bf16, WS_WAU) + (size_t)l * DM * 2 * AW; float* PART = WSP(float, WS_PART);
            { pg8::Gemm g{AOM, wcat, NPT, DM, 2 * AW, 2 * AW}; pg8::StaticOrder S; S.init(NPT, DM, G, bid); EpiGate E{WSP(const bf16, WS_GA), WSP(const bf16, WS_GM), WSP(bf16, WS_MG)}; pg8::gemm_phase<EpiGate, pg8::StaticOrder, true, true>(lds, g, S, E); }
            { pg8::Gemm g{AOM, wcat, MTOK, DM, 256, 2 * AW}; MiniOrder M{0, 8, 8, 256, bid}; EpiPart E{PART, 8, 0}; pg8::gemm_phase<EpiPart, MiniOrder, true, true>(lds, g, M, E); }
        }
        GRID_BAR();
        {
            const bf16* wo = WSP(const bf16, WS_WOUT) + (size_t)l * DM * DM; bf16* MG = WSP(bf16, WS_MG); bf16* XB = WSP(bf16, WS_XB); u64* ssq2 = WSP(u64, WS_STAT) + (size_t)(4 + l) * MTOK;
            float* PART = WSP(float, WS_PART);
            fixup_merge<4>(PART, WSP(const bf16, WS_GA), WSP(const bf16, WS_GM), MG, gw, NGW, lane); split_arrive(ctr + 1);
            { pg8::Gemm g{MG, wo, NPT, DM, DM, DM}; pg8::StaticOrder S; S.init(NPT, DM, G, bid); EpiRes E{XB, nullptr, XB, ssq2}; pg8::gemm_phase<EpiRes, pg8::StaticOrder, true, true>(lds, g, S, E); }
            split_wait(ctr + 1, (unsigned)G);
            { pg8::Gemm g{MG, wo, MTOK, DM, 256, DM}; MiniOrder M{0, 8, 8, 256, bid}; EpiPart E{PART, 8, 0}; pg8::gemm_phase<EpiPart, MiniOrder, true, true>(lds, g, M, E); }
        }
        GRID_BAR();
        {
            const bf16* w1 = WSP(const bf16, WS_W1) + (size_t)l * FFD * DM; bf16* XB = WSP(bf16, WS_XB); bf16* F = WSP(bf16, WS_F); u64* ssq2 = WSP(u64, WS_STAT) + (size_t)(4 + l) * MTOK;
            float* PART = WSP(float, WS_PART);
            fixup_res<8>(PART, XB, nullptr, XB, ssq2, gw, NGW, lane); split_arrive(ctr + 2);
            { pg8::Gemm g{XB, w1, NPT, FFD, DM, DM}; pg8::StaticOrder S; S.init(NPT, FFD, G, bid); EpiFF1 E{ssq2, F}; pg8::gemm_phase<EpiFF1, pg8::StaticOrder, true, true>(lds, g, S, E); }
#ifdef PROBE_P5
            { pg8::Gemm g{XB, w1, NPT, FFD, DM, DM}; pg8::StaticOrder S; S.init(NPT, FFD, G, bid); EpiFF1 E{ssq2, F}; pg8::gemm_phase<EpiFF1, pg8::StaticOrder, true, true>(lds, g, S, E); }
#endif
            split_wait(ctr + 2, (unsigned)G);
            { pg8::Gemm g{XB, w1, MTOK, FFD, 512, DM}; MiniOrder M{0, 32, 4, 512, bid}; EpiPart E{PART, 4, 0}; pg8::gemm_phase<EpiPart, MiniOrder, true, true>(lds, g, M, E); }
        }
        GRID_BAR();
        {
            const bf16* w2 = WSP(const bf16, WS_W2) + (size_t)l * DM * FFD; bf16* XB = WSP(bf16, WS_XB); bf16* F = WSP(bf16, WS_F); u64* ssq1n = (l + 1 < NLAYER) ? WSP(u64, WS_STAT) + (size_t)(l + 1) * MTOK : nullptr;
            float* PART = WSP(float, WS_PART);
            fixup_ff1<4>(PART, WSP(const u64, WS_STAT) + (size_t)(4 + l) * MTOK, F, gw, NGW, lane); split_arrive(ctr + 3);
            { pg8::Gemm g{F, w2, NPT, DM, FFD, FFD}; pg8::StaticOrder S; S.init(NPT, DM, G, bid); EpiRes E{XB, (l + 1 < NLAYER) ? nullptr : p.out, (l + 1 < NLAYER) ? XB : nullptr, ssq1n};     pg8::gemm_phase<EpiRes, pg8::StaticOrder, true, true>(lds, g, S, E); }
            split_wait(ctr + 3, (unsigned)G);
            { pg8::Gemm g{F, w2, MTOK, DM, 512, FFD}; MiniOrder M{0, 8, 16, 512, bid}; EpiPart E{PART, 16, 0}; pg8::gemm_phase<EpiPart, MiniOrder, true, true>(lds, g, M, E); }
        }
        GRID_BAR();
    }
    fixup_res<16>(WSP(float, WS_PART), WSP(const bf16, WS_XB), p.out, nullptr, nullptr, gw, NGW, lane);
}

extern "C" void kernel_launch(void* const* d_in, const int* in_sizes, int n_in, void* d_out, int out_size, void* d_ws, size_t ws_size, hipStream_t stream) {
    static int grid = 0;
    if (grid == 0) {
        if (n_in != 19 || out_size != (int)O_END || ws_size < WS_END) { fprintf(stderr, "kernel_launch: unexpected shapes (n_in %d, out %d, ws %zu)\n", n_in, out_size, ws_size); grid = -1; return; }
        int dev = 0, cus = 0, per_cu = 0;
        (void)hipGetDevice(&dev); (void)hipDeviceGetAttribute(&cus, hipDeviceAttributeMultiprocessorCount, dev);
        if (hipFuncSetAttribute((const void*)fwd_kernel, hipFuncAttributeMaxDynamicSharedMemorySize, LDS_BYTES) != hipSuccess) { fprintf(stderr, "kernel_launch: hipFuncSetAttribute failed\n"); grid = -1; return; }
        if (hipOccupancyMaxActiveBlocksPerMultiprocessor(&per_cu, (const void*)fwd_kernel, 512, LDS_BYTES) != hipSuccess || per_cu < 1) { fprintf(stderr, "kernel_launch: occupancy query says %d\n", per_cu); per_cu = 1; }
        (void)hipGetLastError();
        grid = cus > 0 ? cus : 256;
    }
    if (grid < 0) return;
    Params p{};
    const float** pp = (const float**)&p;
    for (int i = 0; i < 19; ++i) pp[i] = (const float*)d_in[i];
    p.out = (float*)d_out; p.ws = (unsigned char*)d_ws;
    (void)hipMemsetAsync((unsigned char*)d_ws + WS_CNT, 0, 131072, stream);
    void* args[] = {&p};
    hipError_t e = hipLaunchCooperativeKernel((const void*)fwd_kernel, dim3(grid), dim3(512), args, LDS_BYTES, stream);
    if (e != hipSuccess) fprintf(stderr, "kernel_launch: cooperative launch failed: %s (grid %d)\n", hipGetErrorString(e), grid);
}
```
